# Optimizing an MI355X kernel written in HIP

```python
import jax, jax.numpy as jnp
from jax import lax
import numpy as np

D_MODEL = 2048
BATCH = 8
SEQ = 2048
DEPTH = 2

M_HEADS = 4
M_QK = 128
M_V = 256
M_QK_W = M_HEADS * M_QK
M_V_W = M_HEADS * M_V
M_CHUNK = 128
MLA_HEADS = 8
NOPE_DIM = 128
ROPE_DIM = 64
QK_DIM = NOPE_DIM + ROPE_DIM
MLA_V = 128
MLA_W = MLA_HEADS * MLA_V
Q_RANK = 512
KV_RANK = 256
ROPE_THETA = 10000.0
Q_BLOCK = 128
POOL_WINDOWS = (2, 4, 8, 16)
POOL_GROUPS = 4
POOL_GROUP_W = 256
POOL_W = POOL_GROUPS * POOL_GROUP_W
N_BRANCH = 3
BRANCH_W = 1024
FFN_DIM = ((8 * D_MODEL // 3 + 255) // 256) * 256
NORM_EPS = 1e-6
IN_SIZES = (M_QK_W, M_QK_W, M_V_W, M_V_W, M_HEADS, M_HEADS, Q_RANK, KV_RANK, ROPE_DIM, POOL_W, N_BRANCH * D_MODEL)
IN_W = sum(IN_SIZES)

kernel_name = "hybrid_mlstm_mla_pool_adaln"


def rmsnorm(x, g):
    xf = x.astype(jnp.float32)
    y = xf * lax.rsqrt(jnp.mean(xf * xf, axis=-1, keepdims=True) + NORM_EPS)
    return (y * g.astype(jnp.float32)).astype(x.dtype)


def modulate(h, shift, scale):
    return h * (1 + scale[:, None, :]) + shift[:, None, :]


def split_cols(z, sizes):
    out = []
    off = 0
    for s in sizes:
        out.append(z[..., off:off + s])
        off += s
    return out


def rope(x):
    S, R = x.shape[1], x.shape[-1]
    pos = jnp.arange(S, dtype=jnp.float32)
    freqs = ROPE_THETA ** (-jnp.arange(0, R, 2, dtype=jnp.float32) / R)
    ang = pos[:, None] * freqs[None, :]
    cos = jnp.cos(ang)[None, :, None, :].astype(x.dtype)
    sin = jnp.sin(ang)[None, :, None, :].astype(x.dtype)
    x1, x2 = x[..., : R // 2], x[..., R // 2:]
    return jnp.concatenate([x1 * cos - x2 * sin, x1 * sin + x2 * cos], axis=-1)


def causal_attention(q, k, v):
    S, Dh = q.shape[1], q.shape[-1]
    scale = Dh ** -0.5
    outs = []
    for blk in range(S // Q_BLOCK):
        s0, s1 = blk * Q_BLOCK, (blk + 1) * Q_BLOCK
        logits = jnp.einsum('bqhd,bkhd->bhqk', q[:, s0:s1], k[:, :s1],
                            preferred_element_type=jnp.float32) * scale
        mask = (s0 + jnp.arange(Q_BLOCK))[:, None] >= jnp.arange(s1)[None, :]
        logits = jnp.where(mask, logits, -jnp.inf)
        p = jax.nn.softmax(logits, axis=-1).astype(v.dtype)
        outs.append(jnp.einsum('bhqk,bkhv->bqhv', p, v[:, :s1]))
    return jnp.concatenate(outs, axis=1)


def mlstm_chunkwise(q, k, v, i_pre, f_pre):
    f32 = jnp.float32
    B, S, H, DK = q.shape
    DV = v.shape[-1]
    L = M_CHUNK
    NC = S // L
    q = q.astype(f32)
    k = k.astype(f32) * (DK ** -0.5)
    v = v.astype(f32)
    ig = i_pre.astype(f32)
    logf = jax.nn.log_sigmoid(f_pre.astype(f32))

    def to_chunks(a):
        return jnp.moveaxis(a.reshape((B, NC, L) + a.shape[2:]), (1, 3), (0, 2))

    qc, kc, vc = to_chunks(q), to_chunks(k), to_chunks(v)
    ic = to_chunks(ig)
    bc = jnp.cumsum(to_chunks(logf), axis=-1)
    tril = jnp.tril(jnp.ones((L, L), dtype=bool))

    def step(carry, inp):
        C, n, m = carry
        qb, kb, vb, ib, bb = inp
        a = bb + m[..., None]
        Dm = bb[..., :, None] - bb[..., None, :] + ib[..., None, :]
        Dm = jnp.where(tril, Dm, -jnp.inf)
        m_t = jnp.maximum(a, jnp.max(Dm, axis=-1))
        w_inter = jnp.exp(a - m_t)
        s = jnp.einsum('bhtd,bhsd->bhts', qb, kb) * jnp.exp(Dm - m_t[..., None])
        num = (w_inter[..., None] * jnp.einsum('bhvd,bhtd->bhtv', C, qb)
               + jnp.einsum('bhts,bhsv->bhtv', s, vb))
        den = w_inter * jnp.einsum('bhd,bhtd->bht', n, qb) + jnp.sum(s, axis=-1)
        h = num / jnp.maximum(jnp.abs(den), jnp.exp(-m_t))[..., None]
        bL = bb[..., -1]
        g = bL[..., None] - bb + ib
        m_new = jnp.maximum(bL + m, jnp.max(g, axis=-1))
        decay = jnp.exp(bL + m - m_new)
        ws = jnp.exp(g - m_new[..., None])
        C_new = decay[..., None, None] * C + jnp.einsum('bhs,bhsv,bhsd->bhvd', ws, vb, kb)
        n_new = decay[..., None] * n + jnp.einsum('bhs,bhsd->bhd', ws, kb)
        return (C_new, n_new, m_new), h

    init = (jnp.zeros((B, H, DV, DK), f32), jnp.zeros((B, H, DK), f32), jnp.zeros((B, H), f32))
    _, hs = lax.scan(step, init, (qc, kc, vc, ic, bc))
    return jnp.moveaxis(hs, (0, 2), (1, 3)).reshape(B, S, H, DV)


def pool_mixer(u, w_pool, b_pool, s_pool):
    B, S, _ = u.shape
    uf = u.astype(jnp.float32).reshape(B, S, POOL_GROUPS, POOL_GROUP_W)
    cs = jnp.cumsum(uf, axis=1)
    t = jnp.arange(S)
    outs = []
    for g, w in enumerate(POOL_WINDOWS):
        csg = cs[:, :, g]
        lag = jnp.pad(csg, ((0, 0), (w, 0), (0, 0)))[:, :S]
        cnt = jnp.minimum(t + 1, w).astype(jnp.float32)[None, :, None]
        outs.append((csg - lag) / cnt - uf[:, :, g])
    pooled = jnp.stack(outs, axis=2).astype(u.dtype)
    y = jnp.einsum('bsgc,gce->bsge', pooled, w_pool) + b_pool
    return y.reshape(B, S, POOL_W) * s_pool


def setup_inputs(seed: int = 0) -> dict:
    key = jax.random.key(seed)
    ks = jax.random.split(key, 24)
    f32 = jnp.float32

    def dense(k, shape, fan_in):
        return jax.random.normal(k, shape, f32) * (fan_in ** -0.5)

    def gain(k, shape):
        return 1.0 + 0.1 * jax.random.normal(k, shape, f32)

    kb = jax.random.split(ks[6], 2)
    b_mgate = jnp.stack([0.1 * jax.random.normal(kb[0], (DEPTH, M_HEADS), f32),
                         3.0 + 0.5 * jax.random.normal(kb[1], (DEPTH, M_HEADS), f32)], axis=1)
    return {
        "x": jax.random.normal(ks[0], (BATCH, SEQ, D_MODEL), f32),
        "c": jax.random.normal(ks[1], (BATCH, D_MODEL), f32),
        "w_ada": dense(ks[2], (DEPTH, D_MODEL, 6 * D_MODEL), D_MODEL),
        "b_ada": 0.02 * jax.random.normal(ks[3], (DEPTH, 6 * D_MODEL), f32),
        "g_norm1": gain(ks[4], (DEPTH, D_MODEL)),
        "w_in": dense(ks[5], (DEPTH, D_MODEL, IN_W), D_MODEL),
        "b_mgate": b_mgate,
        "g_mnorm": gain(ks[7], (DEPTH, M_HEADS, M_V)),
        "g_qlat": gain(ks[8], (DEPTH, Q_RANK)),
        "w_uq": dense(ks[9], (DEPTH, Q_RANK, MLA_HEADS * QK_DIM), Q_RANK),
        "g_kvlat": gain(ks[10], (DEPTH, KV_RANK)),
        "w_ukv": dense(ks[11], (DEPTH, KV_RANK, MLA_HEADS * (NOPE_DIM + MLA_V)), KV_RANK),
        "g_qn": gain(ks[12], (DEPTH, QK_DIM)),
        "g_kn": gain(ks[13], (DEPTH, QK_DIM)),
        "w_pool": dense(ks[14], (DEPTH, POOL_GROUPS, POOL_GROUP_W, POOL_GROUP_W), POOL_GROUP_W),
        "b_pool": 0.02 * jax.random.normal(ks[15], (DEPTH, POOL_GROUPS, POOL_GROUP_W), f32),
        "s_pool": gain(ks[16], (DEPTH, POOL_W)),
        "w_branch": dense(ks[17], (DEPTH, N_BRANCH, BRANCH_W, D_MODEL), BRANCH_W),
        "w_out": dense(ks[18], (DEPTH, D_MODEL, D_MODEL), D_MODEL),
        "g_norm2": gain(ks[19], (DEPTH, D_MODEL)),
        "w_ffn_in": dense(ks[20], (DEPTH, D_MODEL, 2 * FFN_DIM), D_MODEL),
        "w_ffn_out": dense(ks[21], (DEPTH, FFN_DIM, D_MODEL), FFN_DIM),
    }


def reference(x, c, w_ada, b_ada, g_norm1, w_in, b_mgate, g_mnorm, g_qlat, w_uq, g_kvlat, w_ukv,
              g_qn, g_kn, w_pool, b_pool, s_pool, w_branch, w_out, g_norm2, w_ffn_in, w_ffn_out):
    B, S, D = x.shape
    c_act = jax.nn.silu(c)
    for l in range(DEPTH):
        mod = c_act @ w_ada[l] + b_ada[l]
        shift1, scale1, gate1, shift2, scale2, gate2 = jnp.split(mod, 6, axis=-1)

        h = modulate(rmsnorm(x, g_norm1[l]), shift1, scale1)
        z = h @ w_in[l]
        q_m, k_m, v_m, o_m, i_m, f_m, q_lat, kv_lat, k_r, u_pool, gates = split_cols(z, IN_SIZES)

        hm = mlstm_chunkwise(q_m.reshape(B, S, M_HEADS, M_QK), k_m.reshape(B, S, M_HEADS, M_QK),
                             v_m.reshape(B, S, M_HEADS, M_V),
                             i_m + b_mgate[l, 0], f_m + b_mgate[l, 1]).astype(x.dtype)
        hm = rmsnorm(hm, g_mnorm[l]) * jax.nn.sigmoid(o_m.reshape(B, S, M_HEADS, M_V))
        br_a = hm.reshape(B, S, M_V_W)

        q = (rmsnorm(q_lat, g_qlat[l]) @ w_uq[l]).reshape(B, S, MLA_HEADS, QK_DIM)
        kv = (rmsnorm(kv_lat, g_kvlat[l]) @ w_ukv[l]).reshape(B, S, MLA_HEADS, NOPE_DIM + MLA_V)
        k_nope, v = kv[..., :NOPE_DIM], kv[..., NOPE_DIM:]
        k = jnp.concatenate([k_nope, jnp.broadcast_to(k_r[:, :, None, :], (B, S, MLA_HEADS, ROPE_DIM))], axis=-1)
        q = rmsnorm(q, g_qn[l])
        k = rmsnorm(k, g_kn[l])
        q = jnp.concatenate([q[..., :NOPE_DIM], rope(q[..., NOPE_DIM:])], axis=-1)
        k = jnp.concatenate([k[..., :NOPE_DIM], rope(k[..., NOPE_DIM:])], axis=-1)
        br_b = causal_attention(q, k, v).reshape(B, S, MLA_W)

        br_c = pool_mixer(u_pool, w_pool[l], b_pool[l], s_pool[l])

        g = jax.nn.sigmoid(gates).reshape(B, S, N_BRANCH, D)
        merged = (g[:, :, 0] * (br_a @ w_branch[l, 0])
                  + g[:, :, 1] * (br_b @ w_branch[l, 1])
                  + g[:, :, 2] * (br_c @ w_branch[l, 2]))
        x = x + gate1[:, None, :] * (merged @ w_out[l])

        h2 = modulate(rmsnorm(x, g_norm2[l]), shift2, scale2)
        gu = h2 @ w_ffn_in[l]
        ff = (jax.nn.silu(gu[..., :FFN_DIM]) * gu[..., FFN_DIM:]) @ w_ffn_out[l]
        x = x + gate2[:, None, :] * ff
    return x
```

```cpp
#include <hip/hip_runtime.h>
#include <cstdio>
#include <cstdint>

#ifndef FA_MLA
#define FA_MLA 1
#endif
#ifndef FA_MLSTM
#define FA_MLSTM 1
#endif
#ifndef REP_THIN
#define REP_THIN 1
#endif
#ifndef REP_ATT
#define REP_ATT 1
#endif
#ifndef REP_G
#define REP_G 1
#endif
#ifndef ML_CHUNKED
#define ML_CHUNKED 1
#endif
#ifndef MK_PER_PHASE
#define MK_PER_PHASE 0
#endif

constexpr int H8_LOG2 = 5, W8_LOG2 = 11;
namespace pg8 {
#define PG8_LAS __attribute__((address_space(3)))
typedef unsigned short bf16_t;
typedef short bf16x8 __attribute__((ext_vector_type(8)));
typedef float f32x4 __attribute__((ext_vector_type(4)));
typedef unsigned u32x4 __attribute__((ext_vector_type(4)));
typedef int i32x4 __attribute__((ext_vector_type(4)));
constexpr int BM = 256, BK = 64, HALF = 128, HTB = HALF * BK * 2  , STAGE_BYTES = 8 * HTB, NXCD = 8, WGM = 8;

__host__ __device__ __forceinline__ int lds_byte(int r, int c) { const int st = (r >> 4) * 2 + (c >> 5), rr = r & 15, cc = c & 31, ob = rr * 64 + cc * 2; return st * 1024 + (ob ^ (((ob >> 9) & 1) << 5)); }
__host__ __device__ __forceinline__ void stage_rc(int b, int& R, int& C) { const int st = b / 1024, sb = b % 1024, swz = sb ^ (((sb >> 9) & 1) << 5); R = (st >> 1) * 16 + swz / 64; C = (st & 1) * 32 + (swz % 64) / 2; }
__host__ __device__ __forceinline__ int perm32(int rho) { const int n = rho >> 4, i = rho & 15; return 8 * (i >> 2) + 4 * n + (i & 3); }

struct Unit { int pm, pn, kofs; };
struct Gemm { const bf16_t* A; const bf16_t* Bt; int M, N, K, lda, ldb, a_pn_step; };

struct StaticOrder {
    int nM, nN, nwg, G, c;
    __host__ __device__ void init(int M, int N, int G_, int c_) { nM = M / BM; nN = N / BM; nwg = nM * nN; G = G_; c = c_; }
    __host__ __device__ bool next(int i, Unit& u) const {
        const long L = (long)i * G + c; if (L >= nwg) return false;
        int wgid = (int)L; { const int q = nwg / NXCD, r = nwg % NXCD, xcd = wgid % NXCD, off = wgid / NXCD; wgid = (xcd < r ? xcd * (q + 1) : r * (q + 1) + (xcd - r) * q) + off; }
        const int nig = WGM * nN, gid = wgid / nig, fm = gid * WGM, gsz = (nM - fm) < WGM ? (nM - fm) : WGM;
        u.pm = fm + ((wgid % nig) % gsz); u.pn = (wgid % nig) / gsz; u.kofs = 0; return true;
    }
    __device__ __forceinline__ void a_ready(const Unit&) const {}
    __device__ __forceinline__ void done(const Unit&) const {}
};
struct SkipOrder : StaticOrder {
    int lo, gap;
    __host__ __device__ bool next(int i, Unit& u) const { if (!StaticOrder::next(i, u)) return false; if (u.pn >= lo) u.pn += gap; return true; }
};
template <int NSEG> struct SegOrder : StaticOrder {
    int seg_bytes;
    __host__ __device__ bool next(int i, Unit& u) const { if (!StaticOrder::next(i / NSEG, u)) return false; u.kofs = (i % NSEG) * seg_bytes; return true; }
};

__device__ __forceinline__ unsigned cvt_pk_bf16(float lo, float hi) { unsigned r; asm volatile("v_cvt_pk_bf16_f32 %0, %1, %2" : "=v"(r) : "v"(lo), "v"(hi)); return r; }

template <class Epi, class Sched, bool ALIGN_EPI = true, bool F8 = false>
__device__ __forceinline__ void gemm_phase(PG8_LAS unsigned char* lds, const Gemm g, const Sched& S, const Epi& E, const int tid) {
    const int wid = __builtin_amdgcn_readfirstlane(tid >> 6), lane = tid & 63, wr = wid >> 2, wc = wid & 3, fr = lane & 15, fq = lane >> 4;
    int K_ = g.K; asm volatile("" : "+s"(K_));
    const int K = K_, nt = K / BK;
    unsigned voffA[2], voffB[2];
#pragma unroll
    for (int i = 0; i < 2; ++i) { int R, C; stage_rc(tid * 16 + i * 8192, R, C); const int Rb = Epi::PERM ? ((R & ~31) + perm32(R & 31)) : R;
        voffA[i] = (unsigned)(R * g.lda + C) * 2u; voffB[i] = (unsigned)(Rb * g.ldb + C) * 2u; }
    const size_t kstep = (size_t)(BK * 2);
    const size_t hstepA = (size_t)HALF * g.lda * 2, hstepB = (size_t)HALF * g.ldb * 2;
    const size_t tstepA = 2 * hstepA, tstepB = 2 * hstepB;
    const unsigned ldsw = (unsigned)wid * 1024u;
    const unsigned ldsb = (unsigned)__builtin_amdgcn_readfirstlane((int)((unsigned)(uintptr_t)lds + ldsw));
    int f8sw = 127 - W8_LOG2, f8sh = 127 - H8_LOG2; if constexpr (F8) { asm volatile("" : "+v"(f8sw), "+v"(f8sh)); }
    const int aoff = lds_byte(wr * 64 + fr, fq * 8), boff = lds_byte(wc * 32 + fr, fq * 8);
#define PG8_SA(b, h) (((b) * 2 + (h)) * HTB)
#define PG8_SB(b, h) ((4 + (b) * 2 + (h)) * HTB)
#define PG8_STAGE(bufoff, gbase, voff) do { _Pragma("unroll") for (int _i = 0; _i < 2; ++_i) { const unsigned m0v_ = ldsb + (unsigned)((bufoff) + _i * 8192); \
        asm volatile("s_nop 4\n\ts_mov_b32 m0, %0\n\ts_nop 0\n\tglobal_load_lds_dwordx4 %1, %2" :: "s"(m0v_), "v"((voff)[_i]), "s"((const char*)(gbase)) : "memory", "m0"); } } while (0)
#define PG8_LDA(dst, b, h) do { _Pragma("unroll") for (int m = 0; m < 4; ++m) _Pragma("unroll") for (int k = 0; k < 2; ++k) dst[m][k] = *(const PG8_LAS bf16x8*)(lds + PG8_SA(b, h) + aoff + m * 2048 + k * 1024); } while (0)
#define PG8_LDB(dst, b, h) do { _Pragma("unroll") for (int n = 0; n < 2; ++n) _Pragma("unroll") for (int k = 0; k < 2; ++k) dst[n][k] = *(const PG8_LAS bf16x8*)(lds + PG8_SB(b, h) + boff + n * 2048 + k * 1024); } while (0)
#define PG8_CAT8(x0, x1) __builtin_shufflevector(__builtin_bit_cast(i32x4, x0), __builtin_bit_cast(i32x4, x1), 0, 1, 2, 3, 4, 5, 6, 7)
#define PG8_MMA(ai, bj, At, Bt) do { __builtin_amdgcn_s_setprio(1); \
        if constexpr (F8) {        \
            _Pragma("unroll") for (int m = 0; m < 4; ++m) _Pragma("unroll") for (int n = 0; n < 2; ++n) \
            asm volatile("s_nop 1\n\tv_mfma_scale_f32_16x16x128_f8f6f4 %0, %1, %2, %0, %3, %4 op_sel_hi:[0,0,0]" : "+v"(acc[ai][bj][m][n]) : "v"(PG8_CAT8(Bt[n][0], Bt[n][1])), "v"(PG8_CAT8(At[m][0], At[m][1])), "v"(f8sw), "v"(f8sh)); } \
        else { _Pragma("unroll") for (int m = 0; m < 4; ++m) _Pragma("unroll") for (int n = 0; n < 2; ++n) _Pragma("unroll") for (int k = 0; k < 2; ++k) \
            acc[ai][bj][m][n] = __builtin_amdgcn_mfma_f32_16x16x32_bf16(Bt[n][k], At[m][k], acc[ai][bj][m][n], 0, 0, 0); } __builtin_amdgcn_s_setprio(0); } while (0)
#define PG8_WAIT_V(n) asm volatile("s_waitcnt vmcnt(" #n ")" ::: "memory")
#define PG8_WAIT_L(n) asm volatile("s_waitcnt lgkmcnt(" #n ")" ::: "memory")
#define PG8_BAR __builtin_amdgcn_s_barrier()
#define PG8_SCHED __builtin_amdgcn_sched_barrier(0)
    Unit cur, nxt; int ui = 0;
    if (!S.next(0, cur)) return;
    f32x4 acc[2][2][4][2];
#pragma unroll
    for (int a = 0; a < 2; ++a)
#pragma unroll
        for (int b = 0; b < 2; ++b)
#pragma unroll
            for (int m = 0; m < 4; ++m)
#pragma unroll
                for (int n = 0; n < 2; ++n) { acc[a][b][m][n] = (f32x4){0.f, 0.f, 0.f, 0.f}; }
    bf16x8 At[4][2], B0[2][2], B1[2][2];
    const char* cA = (const char*)g.A + (size_t)cur.pm * tstepA + (size_t)cur.pn * (size_t)g.a_pn_step + cur.kofs; const char* cB = (const char*)g.Bt + (size_t)cur.pn * tstepB + cur.kofs;
    S.a_ready(cur);
    PG8_STAGE(PG8_SB(0, 0), cB, voffB); PG8_STAGE(PG8_SB(0, 1), cB + hstepB, voffB); PG8_STAGE(PG8_SA(0, 0), cA, voffA); PG8_STAGE(PG8_SA(0, 1), cA + hstepA, voffA);
    PG8_STAGE(PG8_SB(1, 0), cB + kstep, voffB); PG8_STAGE(PG8_SA(1, 0), cA + kstep, voffA); PG8_STAGE(PG8_SB(1, 1), cB + hstepB + kstep, voffB);
    if (wr == 1) PG8_BAR;
    PG8_WAIT_V(8); PG8_BAR;
    PG8_WAIT_V(6); PG8_BAR;
    for (;;) {
        const bool has_next = S.next(ui + 1, nxt);
        const char* nA = has_next ? (const char*)g.A + (size_t)nxt.pm * tstepA + (size_t)nxt.pn * (size_t)g.a_pn_step + nxt.kofs : cA; const char* nB = has_next ? (const char*)g.Bt + (size_t)nxt.pn * tstepB + nxt.kofs : cB;
        for (int t = 0; t < nt; t += 2) {
            const bool last = (t == nt - 2);
            const char* a1 = cA + (size_t)(t + 1) * kstep;
            const char* a2 = last ? nA : cA + (size_t)(t + 2) * kstep; const char* b2 = last ? nB : cB + (size_t)(t + 2) * kstep;
            const char* a3 = a2 + kstep; const char* b3 = b2 + kstep;
            if (last && has_next) S.a_ready(nxt);
            const bool fresh = (t == 0) && (ui > 0);
#define PG8_WAIT_VF() do { if (fresh) asm volatile("s_waitcnt vmcnt(%0)" :: "i"(8 + Epi::NST) : "memory"); else PG8_WAIT_V(8); } while (0)
            PG8_LDB(B0, 0, 0); PG8_LDB(B1, 0, 1); PG8_SCHED; PG8_LDA(At, 0, 0); if (!fresh) PG8_STAGE(PG8_SA(1, 1), a1 + hstepA, voffA);
            PG8_WAIT_VF(); PG8_WAIT_L(0); PG8_BAR; PG8_MMA(0, 0, At, B0); PG8_MMA(0, 1, At, B1); PG8_BAR; PG8_SCHED;
            PG8_LDA(At, 0, 1); PG8_STAGE(PG8_SB(0, 0), b2, voffB); PG8_STAGE(PG8_SB(0, 1), b2 + hstepB, voffB); PG8_STAGE(PG8_SA(0, 0), a2, voffA);
            PG8_WAIT_VF(); PG8_WAIT_L(0); PG8_BAR; PG8_MMA(1, 0, At, B0); PG8_MMA(1, 1, At, B1); PG8_BAR; PG8_SCHED;
            PG8_LDB(B0, 1, 0); PG8_LDB(B1, 1, 1); PG8_SCHED; PG8_LDA(At, 1, 0); PG8_STAGE(PG8_SA(0, 1), a2 + hstepA, voffA);
            PG8_WAIT_VF(); PG8_WAIT_L(0); PG8_BAR; PG8_MMA(0, 0, At, B0); PG8_MMA(0, 1, At, B1); PG8_BAR; PG8_SCHED;
#undef PG8_WAIT_VF
            PG8_LDA(At, 1, 1); PG8_STAGE(PG8_SB(1, 0), b3, voffB); PG8_STAGE(PG8_SB(1, 1), b3 + hstepB, voffB); PG8_STAGE(PG8_SA(1, 0), a3, voffA);
            PG8_WAIT_V(8); PG8_WAIT_L(0); PG8_BAR; PG8_MMA(1, 0, At, B0); PG8_MMA(1, 1, At, B1); PG8_BAR; PG8_SCHED;
        }
        if constexpr (F8) asm volatile("s_nop 15\n\ts_nop 15" ::: "memory");
        if constexpr (ALIGN_EPI) { if (wr == 0) PG8_BAR; }
        if (has_next) PG8_STAGE(PG8_SA(1, 1), nA + kstep + hstepA, voffA);
        bool keep = false;
        int ln_e; asm volatile("v_mbcnt_lo_u32_b32 %0, -1, 0\n\tv_mbcnt_hi_u32_b32 %0, -1, %0" : "=v"(ln_e));
        const int fr_e = ln_e & 15, fq_e = ln_e >> 4;
        if constexpr (Epi::CHAIN) keep = E.chain(acc, cur, wr, wc, fr_e, fq_e); else E(acc, cur, wr, wc, fr_e, fq_e);
        S.done(cur);
        if (!has_next) break;
        if (!keep) {
#pragma unroll
        for (int a = 0; a < 2; ++a)
#pragma unroll
            for (int b = 0; b < 2; ++b)
#pragma unroll
                for (int m = 0; m < 4; ++m)
#pragma unroll
                    for (int n = 0; n < 2; ++n) { acc[a][b][m][n] = (f32x4){0.f, 0.f, 0.f, 0.f}; }
        }
        cur = nxt; cA = nA; cB = nB; ++ui;
        if constexpr (ALIGN_EPI) { if (wr == 1) PG8_BAR; }
    }
    PG8_WAIT_V(0);
    if constexpr (!ALIGN_EPI) { if (wr == 0) PG8_BAR; }
    PG8_BAR;
#undef PG8_SA
#undef PG8_SB
#undef PG8_STAGE
#undef PG8_LDA
#undef PG8_LDB
#undef PG8_MMA
#undef PG8_CAT8
#undef PG8_WAIT_V
#undef PG8_WAIT_L
#undef PG8_BAR
#undef PG8_SCHED
}
}

constexpr int NB = 8, SEQ = 2048, DM = 2048, M = NB * SEQ, DEPTH = 2;
constexpr int IN_W = 11080, ZW = 11264;
constexpr int ZQ = 0, ZK = 512, ZV = 1024, ZO = 2048, ZQL = 3072, ZKVL = 3584, ZKR = 3840, ZIF = 3904, ZU = 4096, ZG = 5120;
constexpr int FF = 5632, ADA = 6 * DM;
constexpr float EPS = 1e-6f;
constexpr int QW = 1536, KVW = 2048, BRW = 3072;
constexpr float LOG2E = 1.4426950408889634f;

constexpr size_t MiB = 1u << 20;
constexpr size_t WS_CTL = 0, CTL_ZERO_BYTES = 64 * 1024;
constexpr size_t WS_MOD = 1 * MiB;
constexpr size_t WS_ROPE = 2 * MiB;
constexpr size_t WS_RSTD = 2 * MiB + 512 * 1024;
constexpr size_t WS_GP = 2 * MiB + 768 * 1024;
constexpr size_t WS_IF = 3 * MiB;
constexpr size_t WS_ML = 4 * MiB;
constexpr int ML_ECH = 6 * 32 * 2048, ML_FQ = 7 * 32 * 2048, ML_FA = 8 * 32 * 2048, ML_FB = ML_FA + 512, ML_DN = 9 * 32 * 2048;
constexpr int MCH = 128, NCH = 16;
constexpr size_t WS_WIN = 8 * MiB, WS_WUQ = WS_WIN + 44 * MiB, WS_WUKV = WS_WUQ + 3 * MiB / 2, WS_WPOOL = WS_WUKV + 1 * MiB, WS_WBR = WS_WPOOL + MiB / 2,
                 WS_WOUT = WS_WBR + 12 * MiB, WS_WFFI = WS_WOUT + 8 * MiB, WS_WFFO = WS_WFFI + 44 * MiB;
constexpr size_t WS_XB = 141 * MiB;
constexpr size_t WS_Z = 205 * MiB;
constexpr size_t WS_QRAW = 557 * MiB;
constexpr size_t WS_KVRAW = 605 * MiB;
constexpr size_t WS_MERGED = WS_QRAW;
constexpr size_t WS_KF = 669 * MiB;
constexpr size_t WS_KR = WS_KF, WS_RK = WS_KF + 4 * MiB;
constexpr size_t WS_BR = 717 * MiB;
constexpr size_t WS_H8 = WS_BR + 64 * MiB;
constexpr size_t WS_W8 = WS_WIN + 20 * MiB;
constexpr int NZB = 4096 / 256, NZG = 7168 / 256;
constexpr int NZO = 1024 / 256;
constexpr size_t WS_H = WS_BR;
constexpr size_t WS_DCS = 813 * MiB;
constexpr size_t WS_END = 843 * MiB;
static_assert(WS_WFFO + 22 * MiB == WS_XB && WS_XB + 64 * MiB == WS_Z && WS_Z + 352 * MiB == WS_QRAW && WS_QRAW + 48 * MiB == WS_KVRAW && WS_KVRAW + 64 * MiB == WS_KF && WS_KF + 48 * MiB == WS_BR && WS_BR + 96 * MiB == WS_DCS && WS_DCS + 30 * MiB == WS_END, "ws map");

constexpr int CW_BAR = 4096;

constexpr int RING_BYTES = 162816, LDSCTL_OFF = RING_BYTES, MISC_OFF = LDSCTL_OFF + 320, LDS_BYTES = 163840;
constexpr int NWAVES = 8;

#define GAS __attribute__((address_space(1)))
#define LAS __attribute__((address_space(3)))
typedef unsigned short bf16;
typedef unsigned v4u __attribute__((ext_vector_type(4)));
typedef unsigned v2u __attribute__((ext_vector_type(2)));
typedef float f32x4 __attribute__((ext_vector_type(4)));
typedef float f32x2 __attribute__((ext_vector_type(2)));
#define LDS_WAIT() asm volatile("s_waitcnt lgkmcnt(0)" ::: "memory")
#define VM_WAIT() asm volatile("s_waitcnt vmcnt(0)" ::: "memory")
__device__ __forceinline__ unsigned f2bf(float f) { unsigned u = __builtin_bit_cast(unsigned, f); return (u + 0x7fffu + ((u >> 16) & 1u)) >> 16; }
__device__ __forceinline__ unsigned pk2(float lo, float hi) { return f2bf(lo) | (f2bf(hi) << 16); }
__device__ __forceinline__ unsigned pk4_fp8(float a, float b, float c, float d) {
    a = fminf(fmaxf(a, -448.f), 448.f); b = fminf(fmaxf(b, -448.f), 448.f); c = fminf(fmaxf(c, -448.f), 448.f); d = fminf(fmaxf(d, -448.f), 448.f);
    int p = 0; p = __builtin_amdgcn_cvt_pk_fp8_f32(a, b, p, false); p = __builtin_amdgcn_cvt_pk_fp8_f32(c, d, p, true); return (unsigned)p; }
__device__ __forceinline__ float bflo(unsigned w) { return __builtin_bit_cast(float, w << 16); }
__device__ __forceinline__ float bfhi(unsigned w) { return __builtin_bit_cast(float, w & 0xffff0000u); }
__device__ __forceinline__ float bf2f(bf16 b) { return __builtin_bit_cast(float, ((unsigned)b) << 16); }
__device__ __forceinline__ float sigmoidf_(float x) { return __builtin_amdgcn_rcpf(1.f + __expf(-x)); }

#define XB_TMO      128
#define XB_XCNT(j)  (256  + 64 * (j))
#define XB_XSUB(j)  (1280 + 64 * (j))
#define XB_XGEN(j)  (2304 + 64 * (j))
#define XB_TOP      3328
#define XB_TOPGEN   3392
#define XCD_BAR_WORDS 3456
#define XB_SPIN_CAP (1u << 22)
__device__ __forceinline__ unsigned xb_ld(unsigned* p)              { return __hip_atomic_load(p, __ATOMIC_RELAXED, __HIP_MEMORY_SCOPE_AGENT); }
__device__ __forceinline__ unsigned xb_add(unsigned* p, unsigned v) { return __hip_atomic_fetch_add(p, v, __ATOMIC_RELAXED, __HIP_MEMORY_SCOPE_AGENT); }
__device__ __forceinline__ unsigned xb_xcc_id() { return (unsigned)__builtin_amdgcn_s_getreg((3 << 11) | 20) & 0xFu; }
#define XB_SPIN(cond, bar) do { unsigned _sp = 0; while (cond) { __builtin_amdgcn_s_sleep(1); \
    if ((++_sp & 255u) == 0u) { if (xb_ld(&(bar)[XB_TMO])) break; if (_sp > XB_SPIN_CAP) { atomicAdd(&(bar)[XB_TMO], 1u); break; } } } } while (0)
struct XcdBarrier { unsigned* bar; unsigned x; volatile LAS unsigned* st; int wave; };
__device__ __forceinline__ bool xb_leader(int wave) { int ln; asm volatile("v_mbcnt_lo_u32_b32 %0, -1, 0\n\tv_mbcnt_hi_u32_b32 %0, -1, %0" : "=v"(ln)); return wave == 0 && ln == 0; }
__device__ __forceinline__ XcdBarrier xcd_barrier_post(unsigned* bar, volatile LAS unsigned* st, int wave) {
    XcdBarrier b; b.bar = bar; b.x = xb_xcc_id(); b.st = st; b.wave = wave;
    if (xb_leader(wave)) st[2] = xb_add(&bar[XB_XCNT(b.x)], 1u);
    return b;
}
__device__ __forceinline__ void xcd_barrier_complete(unsigned* bar, unsigned x, unsigned& nloc, unsigned& nx) {
    const unsigned G = gridDim.x * gridDim.y * gridDim.z;
    unsigned sum, cnt, mine, sp = 0u;
    for (;;) {
        sum = 0u; cnt = 0u; mine = 0u;
#pragma unroll
        for (unsigned j = 0; j < 16; ++j) { const unsigned c = xb_ld(&bar[XB_XCNT(j)]); sum += c; cnt += (c > 0u) ? 1u : 0u; mine = (j == x) ? c : mine; }
        if (sum == G) break;
        __builtin_amdgcn_s_sleep(1);
        if ((++sp & 255u) == 0u) { if (xb_ld(&bar[XB_TMO])) break; if (sp > XB_SPIN_CAP) { atomicAdd(&bar[XB_TMO], 1u); break; } }
    }
    nloc = mine > 0u ? mine : 1u; nx = cnt > 0u ? cnt : 1u;
}
__device__ __forceinline__ void xcd_barrier(const XcdBarrier& b) {
    asm volatile("s_waitcnt vmcnt(0)" ::: "memory");
    __syncthreads();
    if (xb_leader(b.wave)) {
        unsigned* bar = b.bar;
        __builtin_amdgcn_s_waitcnt(0);
        unsigned nloc = b.st[0], nx = b.st[1];
        if (nloc == 0u) { xcd_barrier_complete(bar, b.x, nloc, nx); b.st[0] = nloc; b.st[1] = nx; }
        const unsigned old = xb_add(&bar[XB_XSUB(b.x)], 1u);
        const unsigned gen = old / nloc;
        if (old + 1u == (gen + 1u) * nloc) {
            __builtin_amdgcn_fence(__ATOMIC_RELEASE, "agent");
            asm volatile("s_waitcnt vmcnt(0)" ::: "memory");
            const unsigned og = xb_add(&bar[XB_TOP], 1u);
            const unsigned tg = og / nx;
            if (og + 1u == (tg + 1u) * nx) xb_add(&bar[XB_TOPGEN], 1u);
            else XB_SPIN(xb_ld(&bar[XB_TOPGEN]) == tg, bar);
            __builtin_amdgcn_fence(__ATOMIC_ACQUIRE, "agent");
            xb_add(&bar[XB_XGEN(b.x)], 1u);
            asm volatile("s_waitcnt vmcnt(0)" ::: "memory");
        } else {
            XB_SPIN(xb_ld(&bar[XB_XGEN(b.x)]) == gen, bar);
            __builtin_amdgcn_fence(__ATOMIC_ACQUIRE, "agent");
            asm volatile("s_waitcnt vmcnt(0)" ::: "memory");
        }
    }
    __syncthreads();
}

struct Args {
    const float *x, *c, *w_ada, *b_ada, *g_norm1, *w_in, *b_mgate, *g_mnorm, *g_qlat, *w_uq, *g_kvlat, *w_ukv, *g_qn, *g_kn, *w_pool, *b_pool, *s_pool, *w_branch, *w_out, *g_norm2, *w_ffn_in, *w_ffn_out;
    float* out; unsigned char* ws; int gp_lo, gp_hi;
};
typedef const __attribute__((address_space(4))) Args* KArgs;
struct Frame {
    LAS unsigned char* lds;
    int tid, lane, wave, G, gw, NGW;
    int cid;
};
__device__ __forceinline__ bool relaunder(Frame& F) {
    int ln; asm volatile("v_mbcnt_lo_u32_b32 %0, -1, 0\n\tv_mbcnt_hi_u32_b32 %0, -1, %0" : "=v"(ln)); F.lane = ln; F.tid = F.wave * 64 + ln; return true;
}
template <int CTRL, int ROWMASK = 0xF> __device__ __forceinline__ float dppf(float old, float v) {
    return __builtin_bit_cast(float, __builtin_amdgcn_update_dpp(__builtin_bit_cast(int, old), __builtin_bit_cast(int, v), CTRL, ROWMASK, 0xF, false)); }
__device__ __forceinline__ float row16_sum(float v) {
    v += dppf<0xB1>(0.f, v); v += dppf<0x4E>(0.f, v); v += dppf<0x141>(0.f, v); v += dppf<0x140>(0.f, v); return v; }
__device__ __forceinline__ float row16_max(float v) {
    v = fmaxf(v, dppf<0xB1>(v, v)); v = fmaxf(v, dppf<0x4E>(v, v)); v = fmaxf(v, dppf<0x141>(v, v)); v = fmaxf(v, dppf<0x140>(v, v)); return v; }
__device__ __forceinline__ float wave_sum(float v) {
    v = row16_sum(v); v += dppf<0x142, 0xA>(0.f, v); v += dppf<0x143, 0xC>(0.f, v);
    return __builtin_bit_cast(float, __builtin_amdgcn_readlane(__builtin_bit_cast(int, v), 63)); }
__device__ __forceinline__ float wave_max(float v) {
    v = row16_max(v); v = fmaxf(v, dppf<0x142, 0xA>(v, v)); v = fmaxf(v, dppf<0x143, 0xC>(v, v));
    return __builtin_bit_cast(float, __builtin_amdgcn_readlane(__builtin_bit_cast(int, v), 63)); }
__device__ __forceinline__ float lane_get(float v, int src_lane) { return __builtin_bit_cast(float, __builtin_amdgcn_ds_bpermute(src_lane << 2, __builtin_bit_cast(int, v))); }
__device__ __forceinline__ float swap32(float v, int lane) {
    auto rr = __builtin_amdgcn_permlane32_swap(__float_as_uint(v), __float_as_uint(v), false, false); return __uint_as_float(lane < 32 ? rr[1] : rr[0]); }

struct MapIdent { __device__ __forceinline__ int operator()(int n) const { return n; } };
struct MapWin { __device__ __forceinline__ int operator()(int n) const {
    if (n < ZQL) return n;
    if (n < ZKVL) return 3080 + (n - ZQL);
    if (n < ZKR) return 3592 + (n - ZKVL);
    if (n < ZIF) return 3848 + (n - ZKR);
    if (n < ZIF + 8) return 3072 + (n - ZIF);
    if (n < ZU) return -1;
    if (n < ZG) return 3912 + (n - ZU);
    return 4936 + (n - ZG); } };
struct MapFfi { __device__ __forceinline__ int operator()(int n) const { const int pn = n >> 8, r = n & 255; return r < 128 ? 128 * pn + r : FF + 128 * pn + (r - 128); } };
template <class Map>
__device__ __forceinline__ void transpose_item(const float* W, int ldw, const Map& map, bf16* WT, int K, int row_off, int nblk, const float* kscale, LAS float* scr, int item, int lane) {
    const int kb = item / nblk, nb = item % nblk, k0 = 64 * kb, n0 = 32 * nb;
    const int c = map(n0 + (lane & 31));
    float vals[32];
    { const float* wp = W + (size_t)(k0 + (lane >> 5)) * ldw + (c >= 0 ? c : 0);
#pragma unroll
      for (int i = 0; i < 32; ++i) vals[i] = wp[(size_t)(2 * i) * ldw]; }
#pragma unroll
    for (int i = 0; i < 32; ++i) { const int kk = 2 * i + (lane >> 5); float v = (c >= 0) ? vals[i] : 0.f; if (kscale) v *= kscale[k0 + kk]; scr[kk * 33 + (lane & 31)] = v; }
    LDS_WAIT(); asm volatile("" ::: "memory");
    const int ch = lane & 7;
#pragma unroll
    for (int j = 0; j < 4; ++j) { const int n = (lane >> 3) + 8 * j; const LAS float* s = scr + (8 * ch) * 33 + n;
        v4u o; o.x = pk2(s[0 * 33], s[1 * 33]); o.y = pk2(s[2 * 33], s[3 * 33]); o.z = pk2(s[4 * 33], s[5 * 33]); o.w = pk2(s[6 * 33], s[7 * 33]);
        *(GAS v4u*)(WT + (size_t)(row_off + n0 + n) * K + k0 + 8 * ch) = o; }
    LDS_WAIT(); asm volatile("" ::: "memory");
}
struct CvtItem { const float* W; bf16* WT; const float* kscale; int ldw, K, row_off, kind, k0, n0; };
__device__ __forceinline__ int cvt_map(int kind, int n) { return kind == 0 ? n : (kind == 1 ? MapWin()(n) : MapFfi()(n)); }
__device__ __forceinline__ CvtItem cvt_decode(KArgs a, int l, int it) {
    unsigned char* ws = a->ws; CvtItem c; c.kscale = nullptr; c.row_off = 0; c.kind = 0; int nblk;
    constexpr int I_IN = 32 * 44, I_UQ = 8 * 6, I_UKV = 4 * 8, I_POOL = 4 * 4, I_BR = 48 * 8, I_OUT = 32 * 8, I_FFI = 32 * 44;
    int r = it;
    if (r < I_IN) { c.W = a->w_in + (size_t)l * DM * IN_W; c.ldw = IN_W; c.WT = (bf16*)(ws + WS_WIN); c.K = DM; c.kind = 1; nblk = 44; }
    else if ((r -= I_IN) < I_UQ) { c.W = a->w_uq + (size_t)l * 512 * QW; c.ldw = QW; c.WT = (bf16*)(ws + WS_WUQ); c.K = 512; c.kscale = a->g_qlat + l * 512; nblk = 6; }
    else if ((r -= I_UQ) < I_UKV) { c.W = a->w_ukv + (size_t)l * 256 * KVW; c.ldw = KVW; c.WT = (bf16*)(ws + WS_WUKV); c.K = 256; c.kscale = a->g_kvlat + l * 256; nblk = 8; }
    else if ((r -= I_UKV) < I_POOL) { const int g = r >> 2; r &= 3; c.W = a->w_pool + (size_t)(l * 4 + g) * 65536; c.ldw = 256; c.WT = (bf16*)(ws + WS_WPOOL); c.K = 256; c.row_off = g * 256; nblk = 1; }
    else if ((r -= I_POOL) < I_BR) { c.W = a->w_branch + (size_t)l * 3072 * DM; c.ldw = DM; c.WT = (bf16*)(ws + WS_WBR); c.K = 3072; nblk = 8; }
    else if ((r -= I_BR) < I_OUT) { c.W = a->w_out + (size_t)l * DM * DM; c.ldw = DM; c.WT = (bf16*)(ws + WS_WOUT); c.K = DM; nblk = 8; }
    else if ((r -= I_OUT) < I_FFI) { c.W = a->w_ffn_in + (size_t)l * DM * 2 * FF; c.ldw = 2 * FF; c.WT = (bf16*)(ws + WS_WFFI); c.K = DM; c.kind = 2; nblk = 44; }
    else { r -= I_FFI; c.W = a->w_ffn_out + (size_t)l * FF * DM; c.ldw = DM; c.WT = (bf16*)(ws + WS_WFFO); c.K = FF; nblk = 8; }
    c.k0 = 64 * (r / nblk); c.n0 = 256 * (r % nblk);
    return c;
}
__device__ __forceinline__ void convert_weights(Frame& F, KArgs a, int l) {
    constexpr int NITEMS = 32 * 44 + 8 * 6 + 4 * 8 + 4 * 4 + 48 * 8 + 32 * 8 + 32 * 44 + 88 * 8;
    constexpr int TP = 257;
    LAS float* tile = (LAS float*)F.lds;
    static_assert(2 * 64 * TP * 4 <= RING_BYTES, "transposer tiles fit the phase scratch");
    const int tid = F.tid, lr = tid >> 6, c4 = tid & 63, kg = tid & 7, nl = tid >> 3;
    const int bx = F.cid, vcu = (F.G % 8 == 0) ? (bx % 8) * (F.G / 8) + bx / 8 : bx;
    int it = vcu; asm volatile("" : "+s"(it));
#define CV_LOAD(V, D, item) do { if ((item) < NITEMS) { D = cvt_decode(a, l, (item)); const int c_ = cvt_map(D.kind, D.n0 + 4 * c4); const float* wp_ = D.W + (size_t)(D.k0 + lr) * D.ldw + (c_ >= 0 ? c_ : 0); \
        _Pragma("unroll") for (int i = 0; i < 8; ++i) { V[i] = __builtin_nontemporal_load((const f32x4*)(wp_ + (size_t)(8 * i) * D.ldw)); if (c_ < 0) V[i] = (f32x4){0.f, 0.f, 0.f, 0.f}; } } } while (0)
#define CV_STEP(V, D, bufi, item) do { if ((item) < NITEMS) { LAS float* tb = tile + (bufi) * (64 * TP); \
        _Pragma("unroll") for (int i = 0; i < 8; ++i) { LAS float* p = tb + (lr + 8 * i) * TP + 4 * c4; p[0] = V[i].x; p[1] = V[i].y; p[2] = V[i].z; p[3] = V[i].w; } \
        asm volatile("s_waitcnt lgkmcnt(0)" ::: "memory"); __builtin_amdgcn_s_barrier(); asm volatile("" ::: "memory"); \
        const CvtItem me = D; CV_LOAD(V, D, (item) + 2 * F.G); \
        float ks[8]; _Pragma("unroll") for (int j = 0; j < 8; ++j) ks[j] = me.kscale ? me.kscale[me.k0 + 8 * kg + j] : 1.f; \
        _Pragma("unroll") for (int p = 0; p < 4; ++p) { const int n = nl + 64 * p; const LAS float* sp = tb + (8 * kg) * TP + n; \
            if (me.kind == 1 && (me.n0 >= ZG || (me.n0 >= ZO && me.n0 < ZO + 1024))) { const float w8s = (float)(1 << W8_LOG2); v2u o8; const int r8 = me.n0 >= ZG ? 1024 + me.n0 - ZG : me.n0 - ZO; o8.x = pk4_fp8(sp[0] * w8s, sp[TP] * w8s, sp[2 * TP] * w8s, sp[3 * TP] * w8s); o8.y = pk4_fp8(sp[4 * TP] * w8s, sp[5 * TP] * w8s, sp[6 * TP] * w8s, sp[7 * TP] * w8s); \
                *(GAS v2u*)((unsigned char*)me.WT + 20 * MiB + (size_t)(r8 + n) * DM + me.k0 + 8 * kg) = o8; } \
            else { v4u o; o.x = pk2(sp[0] * ks[0], sp[TP] * ks[1]); o.y = pk2(sp[2 * TP] * ks[2], sp[3 * TP] * ks[3]); o.z = pk2(sp[4 * TP] * ks[4], sp[5 * TP] * ks[5]); o.w = pk2(sp[6 * TP] * ks[6], sp[7 * TP] * ks[7]); \
            *(GAS v4u*)(me.WT + (size_t)(me.row_off + me.n0 + n) * me.K + me.k0 + 8 * kg) = o; } } } } while (0)
    f32x4 vA[8], vB[8]; CvtItem dA, dB;
    CV_LOAD(vA, dA, it); CV_LOAD(vB, dB, it + F.G);
    for (; it < NITEMS; it += 2 * F.G) { CV_STEP(vA, dA, 0, it); CV_STEP(vB, dB, 1, it + F.G); }
#undef CV_LOAD
#undef CV_STEP
    asm volatile("s_waitcnt lgkmcnt(0)" ::: "memory"); __builtin_amdgcn_s_barrier(); asm volatile("" ::: "memory");
}

__device__ __forceinline__ void adaln_partials(Frame& F, KArgs a) {
    LAS float* sc = (LAS float*)(F.lds);
    float* part = (float*)(a->ws + WS_Z);
    for (int it = blockIdx.x; it < 2 * 32 * 24; it += F.G) {
        const int l = it / 768, r = it % 768, kc = r / 24, jc = r % 24;
        __syncthreads();
        { const int b = F.tid >> 6, k = F.tid & 63; const float cv = a->c[b * DM + kc * 64 + k]; sc[k * 8 + b] = cv / (1.f + expf(-cv)); }
        __syncthreads();
        const int j = jc * 512 + F.tid;
        const float* w = a->w_ada + ((size_t)l * DM + kc * 64) * ADA + j;
        float acc[8];
#pragma unroll
        for (int b = 0; b < 8; ++b) acc[b] = 0.f;
#pragma unroll 1
        for (int kh = 0; kh < 4; ++kh) {
            float wv[16];
#pragma unroll
            for (int k = 0; k < 16; ++k) wv[k] = __builtin_nontemporal_load(w + (size_t)(kh * 16 + k) * ADA);
#pragma unroll
            for (int k = 0; k < 16; ++k) { const f32x4 s0 = *(const LAS f32x4*)(sc + (kh * 16 + k) * 8), s1 = *(const LAS f32x4*)(sc + (kh * 16 + k) * 8 + 4);
                acc[0] += s0.x * wv[k]; acc[1] += s0.y * wv[k]; acc[2] += s0.z * wv[k]; acc[3] += s0.w * wv[k]; acc[4] += s1.x * wv[k]; acc[5] += s1.y * wv[k]; acc[6] += s1.z * wv[k]; acc[7] += s1.w * wv[k]; } }
#pragma unroll
        for (int b = 0; b < 8; ++b) part[((size_t)(l * 32 + kc) * 8 + b) * ADA + j] = acc[b];
    }
    __syncthreads();
}
__device__ __forceinline__ void rope_table(Frame& F, KArgs a) {
    float* cs = (float*)(a->ws + WS_ROPE); float* sn = cs + SEQ * 32;
    if (F.gw == 0) { float* gp = (float*)(a->ws + WS_GP); for (int i = F.lane; i < DEPTH * 192; i += 64) gp[i] = a->g_qn[i] * ((i % 192) < 128 ? a->g_kn[i] : 1.f); }
    for (int idx = F.gw * 64 + F.lane; idx < SEQ * 32; idx += F.NGW * 64) {
        const int pos = idx >> 5, i = idx & 31;
        const float freq = (float)exp(-(double)i * (9.210340371976184 / 32.0));
        const float ang = (float)pos * freq;
        const double ad = (double)ang; const double kq = rint(ad * 0.6366197723675814);
        double r = fma(-kq, 1.5707963267948966, ad); r = fma(-kq, 6.123233995736766e-17, r);
        const double r2 = r * r;
        const double s = r * (1.0 + r2 * (-1.0 / 6 + r2 * (1.0 / 120 + r2 * (-1.0 / 5040 + r2 * (1.0 / 362880 + r2 * (-1.0 / 39916800 + r2 * (1.0 / 6227020800.0)))))));
        const double c = 1.0 + r2 * (-0.5 + r2 * (1.0 / 24 + r2 * (-1.0 / 720 + r2 * (1.0 / 40320 + r2 * (-1.0 / 3628800 + r2 * (1.0 / 479001600 + r2 * (-1.0 / 87178291200.0)))))));
        const int q = (int)((long long)kq & 3);
        const double sv = (q == 0) ? s : (q == 1) ? c : (q == 2) ? -s : -c;
        const double cv = (q == 0) ? c : (q == 1) ? -s : (q == 2) ? -c : s;
        cs[idx] = (float)cv; sn[idx] = (float)sv;
    }
}
__device__ __forceinline__ void adaln_reduce(Frame& F, KArgs a) {
    const float* part = (const float*)(a->ws + WS_Z); float* mod = (float*)(a->ws + WS_MOD);
    for (int idx = F.gw * 64 + F.lane; idx < 2 * 8 * ADA; idx += F.NGW * 64) {
        const int l = idx / (8 * ADA), r = idx % (8 * ADA), b = r / ADA, j = r % ADA;
        float s = a->b_ada[l * ADA + j];
        for (int kc = 0; kc < 32; ++kc) s += part[((size_t)(l * 32 + kc) * 8 + b) * ADA + j];
        mod[idx] = s;
    }
}

template <bool INBF, bool F8OUT = false>
__device__ __forceinline__ void norm_rows(Frame& F, const void* xin, const float* g, const float* mod_l, int shift_idx, int scale_idx, bf16* H, unsigned char* H8 = nullptr) {
    const int R = (((M + F.NGW - 1) / F.NGW) + 3) & ~3;
    const int m0 = F.gw * R, m1 = (m0 + R < M) ? m0 + R : M;
    int bcur = -1;
    float gs[32], sh[32];
    constexpr int RB = INBF ? 4 : 2;
    for (int m = m0; m < m1; m += RB) {
        const int b = m >> 11;
        if (b != bcur) { bcur = b;
            const float* shp = mod_l + (size_t)b * ADA + shift_idx * DM; const float* scp = mod_l + (size_t)b * ADA + scale_idx * DM;
            if (INBF) {
#pragma unroll
                for (int j = 0; j < 4; ++j) { const int col = 8 * F.lane + 512 * j;
#pragma unroll
                    for (int hh = 0; hh < 2; ++hh) { const f32x4 gv = *(const f32x4*)(g + col + 4 * hh), sv = *(const f32x4*)(scp + col + 4 * hh), hv = *(const f32x4*)(shp + col + 4 * hh);
#pragma unroll
                        for (int e = 0; e < 4; ++e) { gs[8 * j + 4 * hh + e] = gv[e] * (1.f + sv[e]); sh[8 * j + 4 * hh + e] = hv[e]; } } }
            } else {
#pragma unroll
                for (int j = 0; j < 8; ++j) { const int col = 4 * F.lane + 256 * j; const f32x4 gv = *(const f32x4*)(g + col), sv = *(const f32x4*)(scp + col), hv = *(const f32x4*)(shp + col);
#pragma unroll
                    for (int e = 0; e < 4; ++e) { gs[4 * j + e] = gv[e] * (1.f + sv[e]); sh[4 * j + e] = hv[e]; } }
            }
        }
        if (INBF) {
            v4u q[RB][4];
#pragma unroll
            for (int r = 0; r < RB; ++r) { const GAS v4u* xr = (const GAS v4u*)((const bf16*)xin + (size_t)(m + r) * DM) + F.lane;
#pragma unroll
                for (int j = 0; j < 4; ++j) q[r][j] = xr[64 * j]; }
#pragma unroll
            for (int r = 0; r < RB; ++r) { float ss = 0.f;
#pragma unroll
                for (int j = 0; j < 4; ++j) ss += (bflo(q[r][j].x) * bflo(q[r][j].x) + bfhi(q[r][j].x) * bfhi(q[r][j].x)) + (bflo(q[r][j].y) * bflo(q[r][j].y) + bfhi(q[r][j].y) * bfhi(q[r][j].y))
                        + (bflo(q[r][j].z) * bflo(q[r][j].z) + bfhi(q[r][j].z) * bfhi(q[r][j].z)) + (bflo(q[r][j].w) * bflo(q[r][j].w) + bfhi(q[r][j].w) * bfhi(q[r][j].w));
                const float rstd = 1.0f / sqrtf(wave_sum(ss) * (1.f / DM) + EPS);
                GAS v4u* o16 = (GAS v4u*)(H + (size_t)(m + r) * DM) + F.lane;
#pragma unroll
                for (int j = 0; j < 4; ++j) { v4u o;
                    o.x = pk2(bflo(q[r][j].x) * rstd * gs[8 * j + 0] + sh[8 * j + 0], bfhi(q[r][j].x) * rstd * gs[8 * j + 1] + sh[8 * j + 1]); o.y = pk2(bflo(q[r][j].y) * rstd * gs[8 * j + 2] + sh[8 * j + 2], bfhi(q[r][j].y) * rstd * gs[8 * j + 3] + sh[8 * j + 3]);
                    o.z = pk2(bflo(q[r][j].z) * rstd * gs[8 * j + 4] + sh[8 * j + 4], bfhi(q[r][j].z) * rstd * gs[8 * j + 5] + sh[8 * j + 5]); o.w = pk2(bflo(q[r][j].w) * rstd * gs[8 * j + 6] + sh[8 * j + 6], bfhi(q[r][j].w) * rstd * gs[8 * j + 7] + sh[8 * j + 7]);
                    o16[64 * j] = o;
                    if (F8OUT) { const float h8s = (float)(1 << H8_LOG2); v2u o8;
                        o8.x = pk4_fp8((bflo(q[r][j].x) * rstd * gs[8 * j + 0] + sh[8 * j + 0]) * h8s, (bfhi(q[r][j].x) * rstd * gs[8 * j + 1] + sh[8 * j + 1]) * h8s, (bflo(q[r][j].y) * rstd * gs[8 * j + 2] + sh[8 * j + 2]) * h8s, (bfhi(q[r][j].y) * rstd * gs[8 * j + 3] + sh[8 * j + 3]) * h8s);
                        o8.y = pk4_fp8((bflo(q[r][j].z) * rstd * gs[8 * j + 4] + sh[8 * j + 4]) * h8s, (bfhi(q[r][j].z) * rstd * gs[8 * j + 5] + sh[8 * j + 5]) * h8s, (bflo(q[r][j].w) * rstd * gs[8 * j + 6] + sh[8 * j + 6]) * h8s, (bfhi(q[r][j].w) * rstd * gs[8 * j + 7] + sh[8 * j + 7]) * h8s);
                        *(GAS v2u*)(H8 + (size_t)(m + r) * DM + 8 * F.lane + 512 * j) = o8; } } }
        } else {
            f32x4 v[RB][8];
#pragma unroll
            for (int r = 0; r < RB; ++r) { const GAS f32x4* xr = (const GAS f32x4*)((const float*)xin + (size_t)(m + r) * DM) + F.lane;
#pragma unroll
                for (int j = 0; j < 8; ++j) v[r][j] = xr[64 * j]; }
#pragma unroll
            for (int r = 0; r < RB; ++r) { float ss = 0.f;
#pragma unroll
                for (int j = 0; j < 8; ++j) ss += (v[r][j].x * v[r][j].x + v[r][j].y * v[r][j].y) + (v[r][j].z * v[r][j].z + v[r][j].w * v[r][j].w);
                const float rstd = 1.0f / sqrtf(wave_sum(ss) * (1.f / DM) + EPS);
                GAS v2u* o8 = (GAS v2u*)(H + (size_t)(m + r) * DM) + F.lane;
#pragma unroll
                for (int j = 0; j < 8; ++j) { v2u o; o.x = pk2(v[r][j].x * rstd * gs[4 * j + 0] + sh[4 * j + 0], v[r][j].y * rstd * gs[4 * j + 1] + sh[4 * j + 1]); o.y = pk2(v[r][j].z * rstd * gs[4 * j + 2] + sh[4 * j + 2], v[r][j].w * rstd * gs[4 * j + 3] + sh[4 * j + 3]);
                    o8[64 * j] = o;
                    if (F8OUT) { const float h8s = (float)(1 << H8_LOG2);
                        *(GAS unsigned*)(H8 + (size_t)(m + r) * DM + 4 * F.lane + 256 * j) = pk4_fp8((v[r][j].x * rstd * gs[4 * j + 0] + sh[4 * j + 0]) * h8s, (v[r][j].y * rstd * gs[4 * j + 1] + sh[4 * j + 1]) * h8s, (v[r][j].z * rstd * gs[4 * j + 2] + sh[4 * j + 2]) * h8s, (v[r][j].w * rstd * gs[4 * j + 3] + sh[4 * j + 3]) * h8s); } } }
        }
    }
}

template <int W_>
__device__ __forceinline__ void pooled_block(const bf16* Z, bf16* BR, int mb, int ch) {
    const int t0 = mb & (SEQ - 1);
    v4u q[W_ + 3];
#pragma unroll
    for (int r = 0; r < W_ + 3; ++r) { const int dt = r - (W_ - 1); const int mm = (t0 + dt >= 0) ? mb + dt : mb; q[r] = *(const v4u*)(Z + (size_t)mm * ZW + ZU + ch * 8); }
    float S[8];
#pragma unroll
    for (int e = 0; e < 8; ++e) S[e] = 0.f;
#pragma unroll
    for (int r = 0; r < W_ + 3; ++r) {
        const float f[8] = {bflo(q[r].x), bfhi(q[r].x), bflo(q[r].y), bfhi(q[r].y), bflo(q[r].z), bfhi(q[r].z), bflo(q[r].w), bfhi(q[r].w)};
        const float wgt = (t0 + r - (W_ - 1) >= 0) ? 1.f : 0.f;
#pragma unroll
        for (int e = 0; e < 8; ++e) S[e] += wgt * f[e];
        if (r >= W_ - 1) { const int i = r - (W_ - 1), t = t0 + i; const int cnt = (t + 1 < W_) ? t + 1 : W_; const float inv = 1.f / (float)cnt;
            v4u o; o.x = pk2(S[0] * inv - f[0], S[1] * inv - f[1]); o.y = pk2(S[2] * inv - f[2], S[3] * inv - f[3]); o.z = pk2(S[4] * inv - f[4], S[5] * inv - f[5]); o.w = pk2(S[6] * inv - f[6], S[7] * inv - f[7]);
            *(v4u*)(BR + (size_t)(mb + i) * BRW + ch * 8) = o;
            const float g0[8] = {bflo(q[i].x), bfhi(q[i].x), bflo(q[i].y), bfhi(q[i].y), bflo(q[i].z), bfhi(q[i].z), bflo(q[i].w), bfhi(q[i].w)};
            const float wo = (t0 + i - (W_ - 1) >= 0) ? 1.f : 0.f;
#pragma unroll
            for (int e = 0; e < 8; ++e) S[e] -= wo * g0[e]; }
    }
}
__device__ __forceinline__ void prep_pooled(Frame& F, KArgs a) {
    const bf16* Z = (const bf16*)(a->ws + WS_Z); bf16* BR = (bf16*)(a->ws + WS_BR);
    for (int p = F.gw; p < M / 8; p += F.NGW) {
        const int mb = (2 * p + (F.lane >> 5)) * 4, c = F.lane & 31;
        pooled_block<2>(Z, BR, mb, c); pooled_block<4>(Z, BR, mb, 32 + c); pooled_block<8>(Z, BR, mb, 64 + c); pooled_block<16>(Z, BR, mb, 96 + c);
    }
}
__device__ __forceinline__ void prep_rstd(Frame& F, KArgs a) {
    const bf16* Z = (const bf16*)(a->ws + WS_Z); float* RS = (float*)(a->ws + WS_RSTD);
    const int R = (((M + F.NGW - 1) / F.NGW) + 3) & ~3;
    const int m0 = F.gw * R, m1 = (m0 + R < M) ? m0 + R : M;
    for (int m = m0; m < m1; m += 4) {
        v4u q[4], k[4];
#pragma unroll
        for (int r = 0; r < 4; ++r) { q[r] = *(const v4u*)(Z + (size_t)(m + r) * ZW + ZQL + F.lane * 8); k[r] = *(const v4u*)(Z + (size_t)(m + r) * ZW + ZKVL + (F.lane & 31) * 8); }
#pragma unroll
        for (int r = 0; r < 4; ++r) {
            float s = bflo(q[r].x) * bflo(q[r].x) + bfhi(q[r].x) * bfhi(q[r].x) + bflo(q[r].y) * bflo(q[r].y) + bfhi(q[r].y) * bfhi(q[r].y) + bflo(q[r].z) * bflo(q[r].z) + bfhi(q[r].z) * bfhi(q[r].z) + bflo(q[r].w) * bflo(q[r].w) + bfhi(q[r].w) * bfhi(q[r].w);
            float s2 = bflo(k[r].x) * bflo(k[r].x) + bfhi(k[r].x) * bfhi(k[r].x) + bflo(k[r].y) * bflo(k[r].y) + bfhi(k[r].y) * bfhi(k[r].y) + bflo(k[r].z) * bflo(k[r].z) + bfhi(k[r].z) * bfhi(k[r].z) + bflo(k[r].w) * bflo(k[r].w) + bfhi(k[r].w) * bfhi(k[r].w);
            if (F.lane >= 32) s2 = 0.f;
            s = wave_sum(s); s2 = wave_sum(s2);
            if (F.lane == 0) { RS[(m + r) * 2] = 1.0f / sqrtf(s * (1.f / 512) + EPS); RS[(m + r) * 2 + 1] = 1.0f / sqrtf(s2 * (1.f / 256) + EPS); } }
    }
}
__device__ __forceinline__ float logsigmoidf_(float x) { return fminf(x, 0.f) - log1pf(expf(-fabsf(x))); }
__device__ __forceinline__ void prep_mlstm(Frame& F, KArgs a, int l) {
    const float* IFB = (const float*)(a->ws + WS_IF); float* AS = (float*)(a->ws + WS_ML); float* MX = AS + 32 * SEQ; float* EX = MX + 32 * SEQ; float* AS2 = EX + 2 * 32 * SEQ; float* MX2 = AS2 + 32 * SEQ;
    LAS float* wsum = (LAS float*)F.lds; LAS float* wmax = wsum + 8;
    for (int bh = blockIdx.x; bh < 32; bh += F.G) {
        const int b = bh >> 2, h = bh & 3, t0 = 4 * F.tid;
        const float bi = a->b_mgate[l * 8 + h], bfv = a->b_mgate[l * 8 + 4 + h];
        float lf[4], ig[4];
#pragma unroll
        for (int j = 0; j < 4; ++j) { const size_t mm = (size_t)(b * SEQ + t0 + j); lf[j] = logsigmoidf_(IFB[mm * 8 + 4 + h] + bfv); ig[j] = IFB[mm * 8 + h] + bi; }
        const float c0 = lf[0], c1 = c0 + lf[1], c2 = c1 + lf[2], c3 = c2 + lf[3];
        float inc = c3;
#pragma unroll
        for (int o = 1; o < 64; o <<= 1) { const float v = lane_get(inc, F.lane - o); if (F.lane >= o) inc += v; }
        __syncthreads();
        if (F.lane == 63) wsum[F.wave] = inc;
        __syncthreads();
        float woff = 0.f;
        for (int w = 0; w < F.wave; ++w) woff += wsum[w];
        const float ex = woff + inc - c3;
        const float Fv[4] = {ex + c0, ex + c1, ex + c2, ex + c3};
        float av[4], mv[4];
#pragma unroll
        for (int j = 0; j < 4; ++j) av[j] = ig[j] - Fv[j];
        mv[0] = av[0]; mv[1] = fmaxf(mv[0], av[1]); mv[2] = fmaxf(mv[1], av[2]); mv[3] = fmaxf(mv[2], av[3]);
        float imax = mv[3];
#pragma unroll
        for (int o = 1; o < 64; o <<= 1) { const float v = lane_get(imax, F.lane - o); if (F.lane >= o) imax = fmaxf(imax, v); }
        if (F.lane == 63) wmax[F.wave] = imax;
        __syncthreads();
        float emax = -INFINITY;
        for (int w = 0; w < F.wave; ++w) emax = fmaxf(emax, wmax[w]);
        { const float up = lane_get(imax, F.lane - 1); if (F.lane > 0) emax = fmaxf(emax, up); }
        float A2c = mv[3] * LOG2E;
        A2c = row16_max(A2c); A2c = fmaxf(A2c, lane_get(A2c, F.lane ^ 16));
        const float B2c = lane_get(emax, F.lane & 32) * LOG2E;
        const float B2n = fmaxf(B2c, A2c);
        float* MLb = (float*)(a->ws + WS_ML);
        if ((F.lane & 31) == 0) { const int c = F.tid >> 5; MLb[ML_FA + bh * 16 + c] = __builtin_amdgcn_exp2f(B2c - B2n); MLb[ML_FB + bh * 16 + c] = __builtin_amdgcn_exp2f(A2c - B2n); }
#pragma unroll
        for (int j = 0; j < 4; ++j) { const float Mv = fmaxf(emax, mv[j]); const int o = bh * SEQ + t0 + j;
            AS[o] = av[j]; MX[o] = Mv; EX[o] = expf(-Fv[j] - Mv); AS2[o] = av[j] * LOG2E; MX2[o] = Mv * LOG2E;
            MLb[ML_ECH + o] = 0.08838834764831845f * __builtin_amdgcn_exp2f(av[j] * LOG2E - A2c);
            MLb[ML_FQ + o] = __builtin_amdgcn_exp2f(B2c - Mv * LOG2E); }
    }
    __syncthreads();
}

__device__ __forceinline__ void kstats(Frame& F, KArgs a, int l) {
    const bf16* Z = (const bf16*)(a->ws + WS_Z); const bf16* KV = (const bf16*)(a->ws + WS_KVRAW); bf16* KR = (bf16*)(a->ws + WS_KR); float* RK = (float*)(a->ws + WS_RK);
    const float* cs = (const float*)(a->ws + WS_ROPE); const float* sn = cs + SEQ * 32;
    const int fi = F.lane & 31;
    const float gk = a->g_kn[l * 192 + 128 + F.lane];
    const int R = (((M + F.NGW - 1) / F.NGW) + 3) & ~3;
    const int m0 = F.gw * R, m1 = (m0 + R < M) ? m0 + R : M;
    for (int mq = m0; mq < m1; mq += 4) {
        v4u q0[4], q1[4]; float kr[4], c[4], sv[4];
#pragma unroll
        for (int r = 0; r < 4; ++r) { const int m = mq + r, pos = m & (SEQ - 1);
            q0[r] = *(const v4u*)(KV + (size_t)m * KVW + (F.lane >> 4) * 256 + (F.lane & 15) * 8); q1[r] = *(const v4u*)(KV + (size_t)m * KVW + (4 + (F.lane >> 4)) * 256 + (F.lane & 15) * 8);
            kr[r] = bf2f(Z[(size_t)m * ZW + ZKR + F.lane]); c[r] = cs[pos * 32 + fi]; sv[r] = sn[pos * 32 + fi]; }
#pragma unroll
        for (int r = 0; r < 4; ++r) { const int m = mq + r, pos = m & (SEQ - 1), b = m >> 11;
            const float sgn_s = (F.lane < 32) ? -sv[r] : sv[r];
            float s0 = (bflo(q0[r].x) * bflo(q0[r].x) + bfhi(q0[r].x) * bfhi(q0[r].x)) + (bflo(q0[r].y) * bflo(q0[r].y) + bfhi(q0[r].y) * bfhi(q0[r].y)) + (bflo(q0[r].z) * bflo(q0[r].z) + bfhi(q0[r].z) * bfhi(q0[r].z)) + (bflo(q0[r].w) * bflo(q0[r].w) + bfhi(q0[r].w) * bfhi(q0[r].w));
            float s1 = (bflo(q1[r].x) * bflo(q1[r].x) + bfhi(q1[r].x) * bfhi(q1[r].x)) + (bflo(q1[r].y) * bflo(q1[r].y) + bfhi(q1[r].y) * bfhi(q1[r].y)) + (bflo(q1[r].z) * bflo(q1[r].z) + bfhi(q1[r].z) * bfhi(q1[r].z)) + (bflo(q1[r].w) * bflo(q1[r].w) + bfhi(q1[r].w) * bfhi(q1[r].w));
            s0 = row16_sum(s0); s1 = row16_sum(s1);
            const float sr = wave_sum(kr[r] * kr[r]);
            const float y = kr[r] * gk, other = swap32(y, F.lane);
            KR[(size_t)m * 64 + F.lane] = (bf16)f2bf(y * c[r] + other * sgn_s);
            if ((F.lane & 15) == 0) { const int h = F.lane >> 4;
                RK[(size_t)(b * 8 + h) * SEQ + pos] = 1.0f / sqrtf((s0 + sr) * (1.f / 192) + EPS); RK[(size_t)(b * 8 + 4 + h) * SEQ + pos] = 1.0f / sqrtf((s1 + sr) * (1.f / 192) + EPS); } }
    }
}

namespace fa {
typedef short bf16x8 __attribute__((ext_vector_type(8)));
typedef short s16x4 __attribute__((ext_vector_type(4)));
typedef float f32x16 __attribute__((ext_vector_type(16)));
typedef unsigned u32x4 __attribute__((ext_vector_type(4)));
__device__ __forceinline__ int v_st(int k, int c) { const int kk = (k & ~0xC) | ((k & 4) << 1) | ((k & 8) >> 1); return ((kk >> 3) * 4 + (c >> 5)) * 512 + ((kk & 7) * 32 + (c & 31)) * 2; }
__device__ __forceinline__ int v_rd_base(int lane) { return ((lane & 3) << 3) | (((lane >> 2) & 3) << 6) | (((lane >> 4) & 1) << 5) | (((lane >> 5) & 1) << 8); }
constexpr int v_rd_off(int d0, int ks, int half) { return d0 * 512 + ks * 4096 + half * 2048; }
__device__ __forceinline__ int crow(int r, int hi) { return (r & 3) + 8 * (r >> 2) + 4 * hi; }
__device__ __forceinline__ unsigned cvtpk(float lo, float hi) { unsigned r; asm volatile("v_cvt_pk_bf16_f32 %0, %1, %2" : "=v"(r) : "v"(lo), "v"(hi)); return r; }
#define FA_BAR() do { asm volatile("s_waitcnt lgkmcnt(0)" ::: "memory"); __builtin_amdgcn_s_barrier(); asm volatile("" ::: "memory"); } while (0)
#define FA_PK4(P, B_, OUT) do { unsigned a0 = cvtpk(P[B_+0], P[B_+1]), a1 = cvtpk(P[B_+2], P[B_+3]); unsigned b0 = cvtpk(P[B_+4], P[B_+5]), b1 = cvtpk(P[B_+6], P[B_+7]); \
        auto r0 = __builtin_amdgcn_permlane32_swap(a0, b0, false, false); auto r1 = __builtin_amdgcn_permlane32_swap(a1, b1, false, false); \
        u32x4 w = {r0[0], r1[0], r0[1], r1[1]}; OUT = __builtin_bit_cast(bf16x8, w); } while (0)
__device__ __forceinline__ float swap_max(float v) { auto rr = __builtin_amdgcn_permlane32_swap(__float_as_uint(v), __float_as_uint(v), false, false); return fmaxf(__uint_as_float(rr[0]), __uint_as_float(rr[1])); }
__device__ __forceinline__ float swap_add(float v) { auto rr = __builtin_amdgcn_permlane32_swap(__float_as_uint(v), __float_as_uint(v), false, false); return __uint_as_float(rr[0]) + __uint_as_float(rr[1]); }

template <int MODE>
__device__ __forceinline__ void unit(const Frame& F, KArgs a, int l, int bh, int qb) {
    constexpr int DQK = MODE == 0 ? 192 : 128, DVT = MODE == 0 ? 128 : 256, QBR = MODE == 0 ? 256 : 128, NH = MODE == 0 ? 8 : 4;
    constexpr int PK = DQK * 2, KBYTES = 64 * PK, VBYTES = 64 * DVT * 2, KC8 = DQK / 8, VC8 = DVT / 8, NKC = 64 * KC8 / 512, NVC = 64 * VC8 / 512, NQ = DQK / 16;
    int lane_ = F.lane; asm volatile("" : "+v"(lane_));
    const int wid = F.wave, lane = lane_, r32 = lane & 31, hi = lane >> 5;
    const int b = bh / NH, h = bh % NH;
    const int rb = MODE == 0 ? wid : (wid >> 1), vh = MODE == 0 ? 0 : (wid & 1);
    constexpr bool CHK = (MODE == 1) && (ML_CHUNKED != 0);
    const int P0 = qb * QBR, qlo = P0 + rb * 32, qpos = qlo + r32, T0 = CHK ? P0 / 64 : 0, NT = (P0 + QBR) / 64 - T0;
    unsigned char* ws = a->ws;
    const bf16 *Qg, *Kg, *Vg; int qp, kp, vp;
    if (MODE == 0) { Qg = (const bf16*)(ws + WS_QRAW) + (size_t)(b * SEQ) * QW + h * 192; qp = QW; Kg = (const bf16*)(ws + WS_KVRAW) + (size_t)(b * SEQ) * KVW + h * 256; kp = KVW;
                     Vg = (const bf16*)(ws + WS_KVRAW) + (size_t)(b * SEQ) * KVW + h * 256 + 128; vp = KVW; }
    else { const bf16* Zb = (const bf16*)(ws + WS_Z) + (size_t)(b * SEQ) * ZW; Qg = Zb + ZQ + h * 128; Kg = Zb + ZK + h * 128; Vg = Zb + ZV + h * 256; qp = kp = vp = ZW; }
    constexpr int NST = 3;
    LAS unsigned char* K_lds = F.lds; LAS unsigned char* V_lds = F.lds + NST * KBYTES;
    LAS unsigned char* A_lds = F.lds + NST * (KBYTES + VBYTES);
    LAS float* scr = (LAS float*)(F.lds + NST * (KBYTES + VBYTES) + NST * 2048) + wid * 64; LAS float* al_l = scr; LAS float* li_l = scr + 32;
    LAS float* xs = (LAS float*)(F.lds + NST * (KBYTES + VBYTES) + NST * 2048 + 2048);
    static_assert(NST * (KBYTES + VBYTES) + NST * 2048 + 2048 + 1024 <= RING_BYTES, "flash LDS map");
    bf16x8 qr[NQ];
    { const unsigned qoff = (unsigned)(qpos * qp + hi * 8) * 2u;
#pragma unroll
      for (int d0 = 0; d0 < NQ; ++d0) qr[d0] = *(const bf16x8*)((const char*)Qg + qoff + d0 * 32); }
    unsigned kgo[NKC], vgo[NVC];
#pragma unroll
    for (int i = 0; i < NKC; ++i) { const int X = (wid + 8 * i) * 1024 + lane * 16;
        if (X < 16384) { const int row = X >> 8, j = (X >> 4) & 15; kgo[i] = (unsigned)(row * kp) * 2u + (unsigned)((j ^ (row & 15)) << 4); }
        else { const int Y = X - 16384, row = Y >> 7, j = (Y >> 4) & 7; kgo[i] = (unsigned)(row * 128) + (unsigned)((j ^ ((row >> 1) & 7)) << 4); } }
#pragma unroll
    for (int i = 0; i < NVC; ++i) { const int X = (wid + 8 * i) * 1024 + lane * 16, img = X >> 14, Xi = X & 16383, sub = Xi >> 9, within = Xi & 511;
        const int kk = (sub >> 2) * 8 + (within >> 6), k = (kk & ~0xC) | ((kk & 4) << 1) | ((kk & 8) >> 1), col = img * 128 + (sub & 3) * 32 + ((within & 63) >> 1);
        vgo[i] = (unsigned)(k * vp + col) * 2u; }
#define FA_DMA16(ldsaddr, voff, sbase) asm volatile("s_nop 4\n\ts_mov_b32 m0, %0\n\ts_nop 0\n\tglobal_load_lds_dwordx4 %1, %2" :: "s"(ldsaddr), "v"(voff), "s"(sbase) : "memory", "m0")
#define FA_DMA4(ldsaddr, voff, sbase) asm volatile("s_nop 4\n\ts_mov_b32 m0, %0\n\ts_nop 0\n\tglobal_load_lds_dword %1, %2" :: "s"(ldsaddr), "v"(voff), "s"(sbase) : "memory", "m0")
    const unsigned k_m0 = (unsigned)__builtin_amdgcn_readfirstlane((int)((unsigned)(uintptr_t)K_lds + wid * 1024)), v_m0 = (unsigned)__builtin_amdgcn_readfirstlane((int)((unsigned)(uintptr_t)V_lds + wid * 1024)),
                   a_m0 = (unsigned)__builtin_amdgcn_readfirstlane((int)((unsigned)(uintptr_t)A_lds + wid * 256));
    const unsigned lane4 = (unsigned)lane * 4u;
#define FA_ISSUE(t, buf) do { const char* kb_ = (const char*)(Kg + (size_t)((T0 + (t)) * 64) * kp); const char* vb_ = (const char*)(Vg + (size_t)((T0 + (t)) * 64) * vp); const char* kr_ = (const char*)(KRg + (size_t)((T0 + (t)) * 64) * 64); \
        _Pragma("unroll") for (int i = 0; i < NKC; ++i) FA_DMA16(k_m0 + (unsigned)((buf) * KBYTES + 8192 * i), kgo[i], (i < 2 ? kb_ : kr_)); \
        _Pragma("unroll") for (int i = 0; i < NVC; ++i) FA_DMA16(v_m0 + (unsigned)((buf) * VBYTES + 8192 * i), vgo[i], vb_); \
        FA_DMA4(a_m0 + (unsigned)((buf) * 2048), lane4, (const char*)(AS2 + (T0 + (t)) * 64)); } while (0)
    constexpr int NDMA = NKC + NVC + 1;
    f32x16 o[4];
#pragma unroll
    for (int d = 0; d < 4; ++d)
#pragma unroll
        for (int r = 0; r < 16; ++r) o[d][r] = 0.f;
    float m_reg = -1e30f, l_reg = 0.f;
    const float* AS2 = MODE == 1 ? (const float*)(ws + WS_ML) + 4 * 32 * SEQ + bh * SEQ : (const float*)(ws + WS_RK) + (size_t)bh * SEQ;
    const bf16* KRg = (const bf16*)(ws + WS_KR) + (size_t)(b * SEQ) * 64;
    const float Mq = MODE == 1 ? ((const float*)(ws + WS_ML) + 5 * 32 * SEQ)[bh * SEQ + qpos] : 0.f;
    const int hs16 = hi ^ (r32 & 15), hs8 = hi ^ ((r32 >> 1) & 7);
    const unsigned vbase = (unsigned)(uintptr_t)V_lds + vh * 16384 + v_rd_base(lane);
    FA_ISSUE(0, 0);
    if (NT > 1) FA_ISSUE(1, 1);
    if (MODE == 0) {
        const float* gp = (const float*)(ws + WS_GP) + l * 192 + hi * 8;
        const float* csr = (const float*)(ws + WS_ROPE) + (size_t)qpos * 32 + hi * 8; const float* snr = csr + SEQ * 32;
        f32x4 G[8][2];
#pragma unroll
        for (int d0 = 0; d0 < 8; ++d0) { G[d0][0] = *(const f32x4*)(gp + d0 * 16); G[d0][1] = *(const f32x4*)(gp + d0 * 16 + 4); }
        const float qscale = 0.07216878364870322f * LOG2E;
        float ss = 0.f;
#pragma unroll
        for (int d0 = 0; d0 < NQ; ++d0) { const u32x4 w = __builtin_bit_cast(u32x4, qr[d0]);
            ss += (bflo(w.x) * bflo(w.x) + bfhi(w.x) * bfhi(w.x)) + (bflo(w.y) * bflo(w.y) + bfhi(w.y) * bfhi(w.y)) + (bflo(w.z) * bflo(w.z) + bfhi(w.z) * bfhi(w.z)) + (bflo(w.w) * bflo(w.w) + bfhi(w.w) * bfhi(w.w)); }
        const float rq = qscale / sqrtf(swap_add(ss) * (1.f / 192) + EPS);
#pragma unroll
        for (int d0 = 0; d0 < 8; ++d0) { const u32x4 w = __builtin_bit_cast(u32x4, qr[d0]); const f32x4 g0 = G[d0][0], g1 = G[d0][1];
            u32x4 o; o.x = cvtpk(bflo(w.x) * rq * g0.x, bfhi(w.x) * rq * g0.y); o.y = cvtpk(bflo(w.y) * rq * g0.z, bfhi(w.y) * rq * g0.w);
            o.z = cvtpk(bflo(w.z) * rq * g1.x, bfhi(w.z) * rq * g1.y); o.w = cvtpk(bflo(w.w) * rq * g1.z, bfhi(w.w) * rq * g1.w);
            qr[d0] = __builtin_bit_cast(bf16x8, o); }
        __builtin_amdgcn_sched_barrier(0);
        f32x4 GR[4][2], CS[2][2], SN[2][2];
#pragma unroll
        for (int d0 = 0; d0 < 4; ++d0) { GR[d0][0] = *(const f32x4*)(gp + (8 + d0) * 16); GR[d0][1] = *(const f32x4*)(gp + (8 + d0) * 16 + 4); }
#pragma unroll
        for (int q2 = 0; q2 < 2; ++q2) { CS[q2][0] = *(const f32x4*)(csr + q2 * 16); CS[q2][1] = *(const f32x4*)(csr + q2 * 16 + 4); SN[q2][0] = *(const f32x4*)(snr + q2 * 16); SN[q2][1] = *(const f32x4*)(snr + q2 * 16 + 4); }
#pragma unroll
        for (int d0 = 8; d0 < 10; ++d0) { const u32x4 w1 = __builtin_bit_cast(u32x4, qr[d0]), w2 = __builtin_bit_cast(u32x4, qr[d0 + 2]);
            const float x1[8] = {bflo(w1.x), bfhi(w1.x), bflo(w1.y), bfhi(w1.y), bflo(w1.z), bfhi(w1.z), bflo(w1.w), bfhi(w1.w)}, x2[8] = {bflo(w2.x), bfhi(w2.x), bflo(w2.y), bfhi(w2.y), bflo(w2.z), bfhi(w2.z), bflo(w2.w), bfhi(w2.w)};
            float y1[8], y2[8];
#pragma unroll
            for (int e = 0; e < 8; ++e) { const float a1 = x1[e] * rq * GR[d0 - 8][e >> 2][e & 3], a2 = x2[e] * rq * GR[d0 - 6][e >> 2][e & 3], c_ = CS[d0 - 8][e >> 2][e & 3], s_ = SN[d0 - 8][e >> 2][e & 3];
                y1[e] = a1 * c_ - a2 * s_; y2[e] = a2 * c_ + a1 * s_; }
            u32x4 o1, o2; o1.x = cvtpk(y1[0], y1[1]); o1.y = cvtpk(y1[2], y1[3]); o1.z = cvtpk(y1[4], y1[5]); o1.w = cvtpk(y1[6], y1[7]); o2.x = cvtpk(y2[0], y2[1]); o2.y = cvtpk(y2[2], y2[3]); o2.z = cvtpk(y2[4], y2[5]); o2.w = cvtpk(y2[6], y2[7]);
            qr[d0] = __builtin_bit_cast(bf16x8, o1); qr[d0 + 2] = __builtin_bit_cast(bf16x8, o2); }
    }
    if (CHK && qb > 0) {
        const bf16* Sg = (const bf16*)(ws + WS_DCS) + ((size_t)(bh * 15 + qb - 1) * 256 + vh * 128) * 128;
        const float* ng = (const float*)(ws + WS_ML) + ML_DN + (bh * 15 + qb - 1) * 128;
#pragma unroll
        for (int vp = 0; vp < 2; ++vp) { bf16x8 sf[2][8];
#pragma unroll
            for (int q2 = 0; q2 < 2; ++q2)
#pragma unroll
                for (int ks = 0; ks < 8; ++ks) sf[q2][ks] = *(const bf16x8*)(Sg + (size_t)((2 * vp + q2) * 32 + r32) * 128 + ks * 16 + hi * 8);
#pragma unroll
            for (int ks = 0; ks < 8; ++ks) { o[2 * vp] = __builtin_amdgcn_mfma_f32_32x32x16_bf16(qr[ks], sf[0][ks], o[2 * vp], 0, 0, 0); o[2 * vp + 1] = __builtin_amdgcn_mfma_f32_32x32x16_bf16(qr[ks], sf[1][ks], o[2 * vp + 1], 0, 0, 0); } }
        float dotp = 0.f;
#pragma unroll
        for (int ks = 0; ks < 8; ++ks) { const f32x4 n0 = *(const f32x4*)(ng + ks * 16 + hi * 8), n1 = *(const f32x4*)(ng + ks * 16 + hi * 8 + 4); const u32x4 qw = __builtin_bit_cast(u32x4, qr[ks]);
            dotp += (bflo(qw.x) * n0.x + bfhi(qw.x) * n0.y) + (bflo(qw.y) * n0.z + bfhi(qw.y) * n0.w) + (bflo(qw.z) * n1.x + bfhi(qw.z) * n1.y) + (bflo(qw.w) * n1.z + bfhi(qw.w) * n1.w); }
        const float fq = ((const float*)(ws + WS_ML) + ML_FQ)[bh * SEQ + qpos];
        l_reg = fq * dotp;
        if (hi == 0) al_l[r32] = fq; LDS_WAIT();
#pragma unroll
        for (int r = 0; r < 16; ++r) { const float al = al_l[crow(r, hi)];
#pragma unroll
            for (int d = 0; d < 4; ++d) o[d][r] *= al; }
    }
    if (NT > 1) asm volatile("s_waitcnt vmcnt(%0)" :: "i"(NDMA) : "memory"); else VM_WAIT();
    FA_BAR();
    int buf = 0;
    for (int t = 0; t < NT; ++t) {
        const int kb = (T0 + t) * 64;
        if (t + 2 < NT) { const int nb = buf == 0 ? 2 : buf - 1; FA_ISSUE(t + 2, nb); }
        const bool act = kb <= qlo + 31;
        if (act) {
            f32x16 p0, p1;
#pragma unroll
            for (int r = 0; r < 16; ++r) { p0[r] = 0.f; p1[r] = 0.f; }
            const LAS unsigned char* kt = K_lds + buf * KBYTES;
            float w0[16], w1[16];
            if (MODE == 1) {
                const LAS float* a2 = (const LAS float*)(A_lds + (buf * 8 + wid) * 256);
                const int dq = qpos - kb - 4 * hi;
                f32x4 av0[4], av1[4];
#pragma unroll
                for (int g = 0; g < 4; ++g) { av0[g] = *(const LAS f32x4*)(a2 + 8 * g + 4 * hi); av1[g] = *(const LAS f32x4*)(a2 + 32 + 8 * g + 4 * hi); }
                bf16x8 kc0, kc1, kn0, kn1;
                { const LAS unsigned char* ka = kt + r32 * 256 + ((0 ^ hs16) << 4); kc0 = *(const LAS bf16x8*)ka; kc1 = *(const LAS bf16x8*)(ka + 32 * 256); }
#pragma unroll
                for (int d0 = 0; d0 < 8; ++d0) {
                    if (d0 + 1 < 8) { const LAS unsigned char* ka = kt + r32 * 256 + (((2 * (d0 + 1)) ^ hs16) << 4); kn0 = *(const LAS bf16x8*)ka; kn1 = *(const LAS bf16x8*)(ka + 32 * 256); }
                    __builtin_amdgcn_sched_barrier(0);
                    p0 = __builtin_amdgcn_mfma_f32_32x32x16_bf16(kc0, qr[d0], p0, 0, 0, 0);
                    __builtin_amdgcn_sched_barrier(0);
                    { const int r = 2 * d0, g = r >> 2, j = r & 3;
                      const float e0 = 0.08838834764831845f * __builtin_amdgcn_exp2f(av0[g][j] - Mq), e1 = 0.08838834764831845f * __builtin_amdgcn_exp2f(av1[g][j] - Mq);
                      w0[r] = (8 * g + j > dq) ? 0.f : e0; w1[r] = (8 * g + j + 32 > dq) ? 0.f : e1; }
                    __builtin_amdgcn_sched_barrier(0);
                    p1 = __builtin_amdgcn_mfma_f32_32x32x16_bf16(kc1, qr[d0], p1, 0, 0, 0);
                    __builtin_amdgcn_sched_barrier(0);
                    { const int r = 2 * d0 + 1, g = r >> 2, j = r & 3;
                      const float e0 = 0.08838834764831845f * __builtin_amdgcn_exp2f(av0[g][j] - Mq), e1 = 0.08838834764831845f * __builtin_amdgcn_exp2f(av1[g][j] - Mq);
                      w0[r] = (8 * g + j > dq) ? 0.f : e0; w1[r] = (8 * g + j + 32 > dq) ? 0.f : e1; }
                    __builtin_amdgcn_sched_barrier(0);
                    kc0 = kn0; kc1 = kn1;
                }
            } else {
#define FA_KLD(d0_) do { const LAS unsigned char* ka = ((d0_) < 8) ? kt + r32 * 256 + (((2 * (d0_)) ^ hs16) << 4) : kt + 16384 + r32 * 128 + (((2 * ((d0_) - 8)) ^ hs8) << 4); \
                kf[(d0_) & 3][0] = *(const LAS bf16x8*)ka; kf[(d0_) & 3][1] = *(const LAS bf16x8*)(ka + (((d0_) < 8) ? 32 * 256 : 32 * 128)); } while (0)
            { const LAS float* a2 = (const LAS float*)(A_lds + (buf * 8 + wid) * 256);
              f32x4 k0s[4], k1s[4];
#pragma unroll
              for (int g = 0; g < 4; ++g) { k0s[g] = *(const LAS f32x4*)(a2 + 8 * g + 4 * hi); k1s[g] = *(const LAS f32x4*)(a2 + 32 + 8 * g + 4 * hi); }
              bf16x8 kf[4][2];
              FA_KLD(0); FA_KLD(1); FA_KLD(2);
              __builtin_amdgcn_sched_barrier(0);
#pragma unroll
              for (int d0 = 0; d0 < NQ; ++d0) {
                  if (d0 + 3 < NQ) FA_KLD(d0 + 3);
                  __builtin_amdgcn_sched_barrier(0);
                  p0 = __builtin_amdgcn_mfma_f32_32x32x16_bf16(kf[d0 & 3][0], qr[d0], p0, 0, 0, 0);
                  p1 = __builtin_amdgcn_mfma_f32_32x32x16_bf16(kf[d0 & 3][1], qr[d0], p1, 0, 0, 0);
                  __builtin_amdgcn_sched_barrier(0); }
#pragma unroll
              for (int g = 0; g < 4; ++g)
#pragma unroll
                  for (int j = 0; j < 4; ++j) { p0[4 * g + j] *= k0s[g][j]; p1[4 * g + j] *= k1s[g][j]; } }
#undef FA_KLD
            }
            const bool need_mask = kb + 63 > qlo;
            bf16x8 pa0, pa1, pa2, pa3;
            if (MODE == 0) {
                if (need_mask) {
#pragma unroll
                    for (int r = 0; r < 16; ++r) { const int key = kb + crow(r, hi); if (key > qpos) p0[r] = -INFINITY; if (key + 32 > qpos) p1[r] = -INFINITY; } }
                float pmax = p0[0];
#pragma unroll
                for (int r = 1; r < 16; ++r) pmax = fmaxf(pmax, p0[r]);
#pragma unroll
                for (int r = 0; r < 16; ++r) pmax = fmaxf(pmax, p1[r]);
                pmax = swap_max(pmax);
                float mn = m_reg, alpha = 1.f;
                if (!__all(pmax - m_reg <= 8.f)) { mn = fmaxf(m_reg, pmax); alpha = __builtin_amdgcn_exp2f(m_reg - mn); m_reg = mn; }
                float ps = 0.f;
#pragma unroll
                for (int r = 0; r < 16; ++r) { p0[r] = __builtin_amdgcn_exp2f(p0[r] - mn); p1[r] = __builtin_amdgcn_exp2f(p1[r] - mn); ps += p0[r] + p1[r]; }
                ps = swap_add(ps);
                l_reg = l_reg * alpha + ps;
                FA_PK4(p0, 0, pa0); FA_PK4(p0, 8, pa1); FA_PK4(p1, 0, pa2); FA_PK4(p1, 8, pa3);
                if (__any(alpha < 1.f)) { if (hi == 0) al_l[r32] = alpha; LDS_WAIT();
#pragma unroll
                    for (int r = 0; r < 16; ++r) { const float al = al_l[crow(r, hi)];
#pragma unroll
                        for (int d = 0; d < 4; ++d) o[d][r] *= al; } }
            } else {
                float ps = 0.f;
#pragma unroll
                for (int r = 0; r < 16; ++r) { p0[r] *= w0[r]; p1[r] *= w1[r]; ps += p0[r] + p1[r]; }
                l_reg += ps;
                FA_PK4(p0, 0, pa0); FA_PK4(p0, 8, pa1); FA_PK4(p1, 0, pa2); FA_PK4(p1, 8, pa3);
            }
            const unsigned vb = vbase + buf * VBYTES;
#define FA_TRRD(dst, off) asm volatile("ds_read_b64_tr_b16 %0, %1 offset:%2" : "=&v"(dst) : "v"(vb), "i"(off) : "memory")
#define FA_RDKS(set, ks) do { FA_TRRD(set[0], v_rd_off(0, ks, 0)); FA_TRRD(set[1], v_rd_off(0, ks, 1)); FA_TRRD(set[2], v_rd_off(1, ks, 0)); FA_TRRD(set[3], v_rd_off(1, ks, 1)); \
            FA_TRRD(set[4], v_rd_off(2, ks, 0)); FA_TRRD(set[5], v_rd_off(2, ks, 1)); FA_TRRD(set[6], v_rd_off(3, ks, 0)); FA_TRRD(set[7], v_rd_off(3, ks, 1)); } while (0)
#define FA_MMKS(set, pa) do { _Pragma("unroll") for (int d0 = 0; d0 < 4; ++d0) \
            o[d0] = __builtin_amdgcn_mfma_f32_32x32x16_bf16(pa, (bf16x8){set[2 * d0][0], set[2 * d0][1], set[2 * d0][2], set[2 * d0][3], set[2 * d0 + 1][0], set[2 * d0 + 1][1], set[2 * d0 + 1][2], set[2 * d0 + 1][3]}, o[d0], 0, 0, 0); } while (0)
            { s16x4 va[8], vb2[8];
              FA_RDKS(va, 0); FA_RDKS(vb2, 1);
              asm volatile("s_waitcnt lgkmcnt(8)" ::: "memory"); __builtin_amdgcn_sched_barrier(0);
              FA_MMKS(va, pa0); __builtin_amdgcn_sched_barrier(0);
              FA_RDKS(va, 2);
              asm volatile("s_waitcnt lgkmcnt(8)" ::: "memory"); __builtin_amdgcn_sched_barrier(0);
              FA_MMKS(vb2, pa1); __builtin_amdgcn_sched_barrier(0);
              FA_RDKS(vb2, 3);
              asm volatile("s_waitcnt lgkmcnt(8)" ::: "memory"); __builtin_amdgcn_sched_barrier(0);
              FA_MMKS(va, pa2); __builtin_amdgcn_sched_barrier(0);
              asm volatile("s_waitcnt lgkmcnt(0)" ::: "memory"); __builtin_amdgcn_sched_barrier(0);
              FA_MMKS(vb2, pa3); }
#undef FA_MMKS
#undef FA_RDKS
#undef FA_TRRD
        }
        if (t + 2 < NT) asm volatile("s_waitcnt vmcnt(%0)" :: "i"(NDMA) : "memory"); else VM_WAIT();
        FA_BAR();
        buf = buf == 2 ? 0 : buf + 1;
    }
    bf16* BR = (bf16*)(ws + WS_BR);
    const int erow = lane >> 4, ech = lane & 15;
    if (MODE == 0) {
        constexpr int RP = 272;
        LAS unsigned char* sg = F.lds + wid * (32 * RP);
        if (hi == 0) li_l[r32] = l_reg; LDS_WAIT();
#pragma unroll
        for (int r = 0; r < 16; ++r) { const int orow = crow(r, hi); const float rl = __builtin_amdgcn_rcpf(li_l[orow]);
#pragma unroll
            for (int d0 = 0; d0 < 4; ++d0) *(LAS bf16*)(sg + orow * RP + (d0 * 32 + r32) * 2) = (bf16)f2bf(o[d0][r] * rl); }
        LDS_WAIT(); asm volatile("" ::: "memory");
        bf16* Ow = BR + (size_t)(b * SEQ + qlo) * BRW + 1024 + h * 128 + ech * 8;
#pragma unroll
        for (int i = 0; i < 8; ++i) { const int row = 4 * i + erow; const v4u v = *(const LAS v4u*)(sg + row * RP + ech * 16); *(v4u*)(Ow + (size_t)row * BRW) = v; }
    } else {
        constexpr int RP = 528;
        LAS unsigned char* sg = F.lds + wid * (32 * RP);
        static_assert(MODE == 0 || 8 * 32 * RP <= NST * (KBYTES + VBYTES), "mLSTM epilogue images fit the ring");
        const int colb = h * 256 + vh * 128 + ech * 8;
        const bf16* Og = (const bf16*)(ws + WS_Z) + (size_t)(b * SEQ + qlo) * ZW + ZO + colb;
        v4u ogv[8];
#pragma unroll
        for (int i = 0; i < 8; ++i) ogv[i] = *(const v4u*)(Og + (size_t)(4 * i + erow) * ZW);
        const f32x4 g0 = *(const f32x4*)(a->g_mnorm + l * 1024 + colb), g1 = *(const f32x4*)(a->g_mnorm + l * 1024 + colb + 4);
        const float den = swap_add(l_reg);
        const float ex = ((const float*)(ws + WS_ML) + 2 * 32 * SEQ)[bh * SEQ + qpos];
        const float inv = 1.f / fmaxf(fabsf(den), ex);
        if (hi == 0) li_l[r32] = inv; LDS_WAIT();
#pragma unroll
        for (int r = 0; r < 16; ++r) { const int orow = crow(r, hi); const float sc = li_l[orow];
#pragma unroll
            for (int d0 = 0; d0 < 4; ++d0) *(LAS float*)(sg + orow * RP + (d0 * 32 + r32) * 4) = o[d0][r] * sc; }
        LDS_WAIT(); asm volatile("" ::: "memory");
#pragma unroll
        for (int i = 0; i < 8; ++i) { const int row = 4 * i + erow; const f32x4 x0 = *(const LAS f32x4*)(sg + row * RP + ech * 32), x1 = *(const LAS f32x4*)(sg + row * RP + ech * 32 + 16);
            float ss = (x0.x * x0.x + x0.y * x0.y) + (x0.z * x0.z + x0.w * x0.w) + (x1.x * x1.x + x1.y * x1.y) + (x1.z * x1.z + x1.w * x1.w);
            ss = row16_sum(ss);
            if (ech == 0) xs[wid * 32 + row] = ss; }
        FA_BAR();
        bf16* Ow = BR + (size_t)(b * SEQ + qlo) * BRW + colb;
#pragma unroll
        for (int i = 0; i < 8; ++i) { const int row = 4 * i + erow; const f32x4 x0 = *(const LAS f32x4*)(sg + row * RP + ech * 32), x1 = *(const LAS f32x4*)(sg + row * RP + ech * 32 + 16);
            const v4u og = ogv[i];
            const float tot = xs[wid * 32 + row] + xs[(wid ^ 1) * 32 + row]; const float rstd = 1.0f / sqrtf(tot * (1.f / 256) + EPS);
            v4u w; w.x = pk2(x0.x * rstd * g0.x * sigmoidf_(bflo(og.x)), x0.y * rstd * g0.y * sigmoidf_(bfhi(og.x))); w.y = pk2(x0.z * rstd * g0.z * sigmoidf_(bflo(og.y)), x0.w * rstd * g0.w * sigmoidf_(bfhi(og.y)));
            w.z = pk2(x1.x * rstd * g1.x * sigmoidf_(bflo(og.z)), x1.y * rstd * g1.y * sigmoidf_(bfhi(og.z))); w.w = pk2(x1.z * rstd * g1.z * sigmoidf_(bflo(og.w)), x1.w * rstd * g1.w * sigmoidf_(bfhi(og.w)));
            *(v4u*)(Ow + (size_t)row * BRW) = w; }
    }
    FA_BAR();
#undef FA_ISSUE
}

__device__ __forceinline__ void dstate_unit(const Frame& F, KArgs a, int bh, int c) {
    int lane_ = F.lane; asm volatile("" : "+v"(lane_));
    const int wid = F.wave, lane = lane_, r32 = lane & 31, hi = lane >> 5;
    const int b = bh >> 2, h = bh & 3, db = wid & 3, vh = wid >> 2;
    unsigned char* ws = a->ws;
    const bf16* Zb = (const bf16*)(ws + WS_Z) + (size_t)(b * SEQ + c * MCH) * ZW; const bf16* Kg = Zb + ZK + h * 128; const bf16* Vg = Zb + ZV + h * 256;
    const float* Eg = (const float*)(ws + WS_ML) + ML_ECH + bh * SEQ + c * MCH;
    LAS unsigned char* K_lds = F.lds; LAS unsigned char* V_lds = F.lds + 2 * 16384; LAS unsigned char* E_lds = F.lds + 2 * 16384 + 2 * 32768 + wid * 512;
#pragma unroll
    for (int tt = 0; tt < 2; ++tt) {
        const bf16* kb_ = Kg + (size_t)(tt * 64) * ZW; const bf16* vb_ = Vg + (size_t)(tt * 64) * ZW;
#pragma unroll
        for (int i = 0; i < 2; ++i) { const int X = (wid + 8 * i) * 1024 + lane * 16, sub = X >> 9, within = X & 511;
            const int kk = (sub >> 2) * 8 + (within >> 6), k_ = (kk & ~0xC) | ((kk & 4) << 1) | ((kk & 8) >> 1), col = (sub & 3) * 32 + ((within & 63) >> 1);
            __builtin_amdgcn_global_load_lds((const unsigned*)((const char*)kb_ + (unsigned)(k_ * ZW + col) * 2u), (LAS unsigned*)(K_lds + tt * 16384 + (wid + 8 * i) * 1024), 16, 0, 0); }
#pragma unroll
        for (int i = 0; i < 4; ++i) { const int X = (wid + 8 * i) * 1024 + lane * 16, img = X >> 14, Xi = X & 16383, sub = Xi >> 9, within = Xi & 511;
            const int kk = (sub >> 2) * 8 + (within >> 6), k_ = (kk & ~0xC) | ((kk & 4) << 1) | ((kk & 8) >> 1), col = img * 128 + (sub & 3) * 32 + ((within & 63) >> 1);
            __builtin_amdgcn_global_load_lds((const unsigned*)((const char*)vb_ + (unsigned)(k_ * ZW + col) * 2u), (LAS unsigned*)(V_lds + tt * 32768 + (wid + 8 * i) * 1024), 16, 0, 0); }
        __builtin_amdgcn_global_load_lds((const unsigned*)(Eg + tt * 64 + lane), (LAS unsigned*)(E_lds + tt * 256), 4, 0, 0);
    }
    f32x16 o[4];
#pragma unroll
    for (int d = 0; d < 4; ++d)
#pragma unroll
        for (int r = 0; r < 16; ++r) o[d][r] = 0.f;
    float dnp = 0.f;
    VM_WAIT(); FA_BAR();
    const unsigned kbase = (unsigned)(uintptr_t)K_lds + v_rd_base(lane), vbase = (unsigned)(uintptr_t)V_lds + vh * 16384 + v_rd_base(lane);
    const LAS float* Ew = (const LAS float*)E_lds;
    const unsigned kdb = kbase + db * 512;
#define DS_TR(dst, base, off) asm volatile("ds_read_b64_tr_b16 %0, %1 offset:%2" : "=&v"(dst) : "v"(base), "i"(off) : "memory")
#define DS_STEP(tt, ks) do { s16x4 kl, kh2, v0, v1, v2, v3, v4, v5, v6, v7; const unsigned ka = kdb + (tt) * 16384, vb = vbase + (tt) * 32768; \
        DS_TR(kl, ka, v_rd_off(0, ks, 0)); DS_TR(kh2, ka, v_rd_off(0, ks, 1)); \
        DS_TR(v0, vb, v_rd_off(0, ks, 0)); DS_TR(v1, vb, v_rd_off(0, ks, 1)); DS_TR(v2, vb, v_rd_off(1, ks, 0)); DS_TR(v3, vb, v_rd_off(1, ks, 1)); \
        DS_TR(v4, vb, v_rd_off(2, ks, 0)); DS_TR(v5, vb, v_rd_off(2, ks, 1)); DS_TR(v6, vb, v_rd_off(3, ks, 0)); DS_TR(v7, vb, v_rd_off(3, ks, 1)); \
        const f32x4 e0 = *(const LAS f32x4*)(Ew + (tt) * 64 + (ks) * 16 + hi * 8), e1 = *(const LAS f32x4*)(Ew + (tt) * 64 + (ks) * 16 + hi * 8 + 4); \
        asm volatile("s_waitcnt lgkmcnt(0)" ::: "memory"); __builtin_amdgcn_sched_barrier(0); \
          \
        const float x0 = bf2f((bf16)kl[0]) * e0.x, x1 = bf2f((bf16)kl[1]) * e0.y, x2 = bf2f((bf16)kl[2]) * e0.z, x3 = bf2f((bf16)kl[3]) * e0.w; \
        const float x4 = bf2f((bf16)kh2[0]) * e1.x, x5 = bf2f((bf16)kh2[1]) * e1.y, x6 = bf2f((bf16)kh2[2]) * e1.z, x7 = bf2f((bf16)kh2[3]) * e1.w; \
        dnp += ((x0 + x1) + (x2 + x3)) + ((x4 + x5) + (x6 + x7)); \
        u32x4 aw; aw.x = cvtpk(x0, x1); aw.y = cvtpk(x2, x3); aw.z = cvtpk(x4, x5); aw.w = cvtpk(x6, x7); const bf16x8 af = __builtin_bit_cast(bf16x8, aw); \
        o[0] = __builtin_amdgcn_mfma_f32_32x32x16_bf16(af, (bf16x8){v0[0], v0[1], v0[2], v0[3], v1[0], v1[1], v1[2], v1[3]}, o[0], 0, 0, 0); \
        o[1] = __builtin_amdgcn_mfma_f32_32x32x16_bf16(af, (bf16x8){v2[0], v2[1], v2[2], v2[3], v3[0], v3[1], v3[2], v3[3]}, o[1], 0, 0, 0); \
        o[2] = __builtin_amdgcn_mfma_f32_32x32x16_bf16(af, (bf16x8){v4[0], v4[1], v4[2], v4[3], v5[0], v5[1], v5[2], v5[3]}, o[2], 0, 0, 0); \
        o[3] = __builtin_amdgcn_mfma_f32_32x32x16_bf16(af, (bf16x8){v6[0], v6[1], v6[2], v6[3], v7[0], v7[1], v7[2], v7[3]}, o[3], 0, 0, 0); \
        __builtin_amdgcn_sched_barrier(0); } while (0)
    DS_STEP(0, 0); DS_STEP(0, 1); DS_STEP(0, 2); DS_STEP(0, 3); DS_STEP(1, 0); DS_STEP(1, 1); DS_STEP(1, 2); DS_STEP(1, 3);
#undef DS_STEP
#undef DS_TR
    bf16* D = (bf16*)(ws + WS_DCS) + ((size_t)(bh * 15 + c) * 256 + vh * 128) * 128 + db * 32;
#pragma unroll
    for (int vb2 = 0; vb2 < 4; ++vb2)
#pragma unroll
        for (int g = 0; g < 4; ++g) { v2u w; w.x = cvtpk(o[vb2][4 * g], o[vb2][4 * g + 1]); w.y = cvtpk(o[vb2][4 * g + 2], o[vb2][4 * g + 3]);
            *(v2u*)(D + (size_t)(vb2 * 32 + r32) * 128 + 8 * g + 4 * hi) = w; }
    const float dn = swap_add(dnp);
    if (vh == 0 && hi == 0) ((float*)(ws + WS_ML))[ML_DN + (bh * 15 + c) * 128 + db * 32 + r32] = dn;
    FA_BAR();
}
__device__ __forceinline__ void dstate_phase(const Frame& F, KArgs a) {
    const int bx = F.cid, vcu = (F.G % 8 == 0) ? (bx % 8) * (F.G / 8) + bx / 8 : bx;
    for (int it = vcu; it < 32 * 15; it += F.G) dstate_unit(F, a, it / 15, it % 15);
}
__device__ __forceinline__ void dstate_scan(const Frame& F, KArgs a) {
    unsigned char* ws = a->ws; const float* ML = (const float*)(ws + WS_ML); float* MLw = (float*)(ws + WS_ML);
    for (int idx = F.gw * 64 + F.lane; idx < 32 * 4096; idx += F.NGW * 64) {
        const int bh = idx >> 12, e8 = idx & 4095;
        bf16* p = (bf16*)(ws + WS_DCS) + (size_t)bh * 15 * 32768 + e8 * 8;
        v4u x[15];
#pragma unroll
        for (int c = 0; c < 15; ++c) x[c] = *(const v4u*)(p + (size_t)c * 32768);
        float S[8], fav[15], fbv[15];
#pragma unroll
        for (int c = 0; c < 15; ++c) { fav[c] = ML[ML_FA + bh * 16 + c]; fbv[c] = ML[ML_FB + bh * 16 + c]; }
#pragma unroll
        for (int j = 0; j < 8; ++j) S[j] = 0.f;
#pragma unroll
        for (int c = 0; c < 15; ++c) { const float fa = fav[c], fb = fbv[c];
            S[0] = S[0] * fa + bflo(x[c].x) * fb; S[1] = S[1] * fa + bfhi(x[c].x) * fb; S[2] = S[2] * fa + bflo(x[c].y) * fb; S[3] = S[3] * fa + bfhi(x[c].y) * fb;
            S[4] = S[4] * fa + bflo(x[c].z) * fb; S[5] = S[5] * fa + bfhi(x[c].z) * fb; S[6] = S[6] * fa + bflo(x[c].w) * fb; S[7] = S[7] * fa + bfhi(x[c].w) * fb;
            v4u o; o.x = pk2(S[0], S[1]); o.y = pk2(S[2], S[3]); o.z = pk2(S[4], S[5]); o.w = pk2(S[6], S[7]);
            *(v4u*)(p + (size_t)c * 32768) = o; }
    }
    for (int idx = F.gw * 64 + F.lane; idx < 32 * 128; idx += F.NGW * 64) {
        const int bh = idx >> 7, d = idx & 127; float n = 0.f; float dv[15], fav[15], fbv[15];
#pragma unroll
        for (int c = 0; c < 15; ++c) { dv[c] = ML[ML_DN + (bh * 15 + c) * 128 + d]; fav[c] = ML[ML_FA + bh * 16 + c]; fbv[c] = ML[ML_FB + bh * 16 + c]; }
#pragma unroll
        for (int c = 0; c < 15; ++c) { n = n * fav[c] + dv[c] * fbv[c]; MLw[ML_DN + (bh * 15 + c) * 128 + d] = n; }
    }
}
template <int MODE>
__device__ __forceinline__ void phase(const Frame& F, KArgs a, int l) {
    constexpr int NQB = MODE == 0 ? 8 : 16, NPAIR = NQB / 2;
    const int bx = F.cid, vcu = (F.G % 8 == 0) ? (bx % 8) * (F.G / 8) + bx / 8 : bx;
    for (int it = vcu; it < 256; it += F.G) { const int bh = it / NPAIR, p = it % NPAIR;
        for (int u = 0; u < 2; ++u) unit<MODE>(F, a, l, bh, u ? p : NQB - 1 - p); }
}
}

using pg8::Unit; using pg8::cvt_pk_bf16;
struct EpiZ {
    static constexpr bool PERM = true, CHAIN = false; static constexpr int NST = 16;
    bf16* Z; float* IFB;
    __device__ __forceinline__ void operator()(const f32x4 (&acc)[2][2][4][2], const Unit& u, int wr, int wc, int fr, int fq) const {
        const int row0 = u.pm * 256 + wr * 64 + fr, col0 = u.pn * 256 + wc * 32 + 8 * fq;
        const bool gate_tile = (u.pn == 15) && (wc == 2) && (fq == 0);
#pragma unroll
        for (int ai = 0; ai < 2; ++ai)
#pragma unroll
            for (int m = 0; m < 4; ++m) { const int row = row0 + ai * 128 + m * 16; bf16* rowp = Z + (size_t)row * ZW + col0;
#pragma unroll
                for (int bj = 0; bj < 2; ++bj) { f32x4 v0 = acc[ai][bj][m][0], v1 = acc[ai][bj][m][1];
                    if (bj == 0 && gate_tile) { *(f32x4*)(IFB + (size_t)row * 8) = v0; *(f32x4*)(IFB + (size_t)row * 8 + 4) = v1; }
                    pg8::u32x4 w; w.x = cvt_pk_bf16(v0[0], v0[1]); w.y = cvt_pk_bf16(v0[2], v0[3]); w.z = cvt_pk_bf16(v1[0], v1[1]); w.w = cvt_pk_bf16(v1[2], v1[3]);
                    *(pg8::u32x4*)(rowp + bj * 128) = w; } }
    }
};
struct EpiZG {
    static constexpr bool PERM = true, CHAIN = false; static constexpr int NST = 16;
    bf16* Z;
    __device__ __forceinline__ void operator()(const f32x4 (&acc)[2][2][4][2], const Unit& u, int wr, int wc, int fr, int fq) const {
        const int row0 = u.pm * 256 + wr * 64 + fr, gcol0 = (u.pn - NZO) * 256 + wc * 32 + 8 * fq;
        if (u.pn < NZO) {
            const int col0 = ZO + u.pn * 256 + wc * 32 + 8 * fq;
#pragma unroll
            for (int ai = 0; ai < 2; ++ai)
#pragma unroll
                for (int m = 0; m < 4; ++m) { bf16* rowp = Z + (size_t)(row0 + ai * 128 + m * 16) * ZW + col0;
#pragma unroll
                    for (int bj = 0; bj < 2; ++bj) { const f32x4 v0 = acc[ai][bj][m][0], v1 = acc[ai][bj][m][1];
                        pg8::u32x4 w; w.x = cvt_pk_bf16(v0[0], v0[1]); w.y = cvt_pk_bf16(v0[2], v0[3]); w.z = cvt_pk_bf16(v1[0], v1[1]); w.w = cvt_pk_bf16(v1[2], v1[3]);
                        *(pg8::u32x4*)(rowp + bj * 128) = w; } }
            return; }
#pragma unroll
        for (int ai = 0; ai < 2; ++ai)
#pragma unroll
            for (int m = 0; m < 4; ++m) { const int row = row0 + ai * 128 + m * 16;
#pragma unroll
                for (int bj = 0; bj < 2; ++bj) { const f32x4 v0 = acc[ai][bj][m][0], v1 = acc[ai][bj][m][1];
                    unsigned q[8];
#pragma unroll
                    for (int j = 0; j < 4; ++j) { q[j] = (unsigned)(sigmoidf_(v0[j]) * 255.f + 0.5f); q[4 + j] = (unsigned)(sigmoidf_(v1[j]) * 255.f + 0.5f); }
                    v2u w8; w8.x = q[0] | (q[1] << 8) | (q[2] << 16) | (q[3] << 24); w8.y = q[4] | (q[5] << 8) | (q[6] << 16) | (q[7] << 24);
                    *(v2u*)((unsigned char*)Z + (size_t)row * (ZW * 2) + ZG * 2 + gcol0 + bj * 128) = w8; } }
    }
};
struct EpiRowScale {
    static constexpr bool PERM = true, CHAIN = false; static constexpr int NST = 16;
    bf16* O; int ldc; const float* rs; int which;
    __device__ __forceinline__ void operator()(const f32x4 (&acc)[2][2][4][2], const Unit& u, int wr, int wc, int fr, int fq) const {
        const int row0 = u.pm * 256 + wr * 64 + fr, col0 = u.pn * 256 + wc * 32 + 8 * fq;
        float scv[2][4];
#pragma unroll
        for (int ai = 0; ai < 2; ++ai)
#pragma unroll
            for (int m = 0; m < 4; ++m) scv[ai][m] = rs[(row0 + ai * 128 + m * 16) * 2 + which];
#pragma unroll
        for (int ai = 0; ai < 2; ++ai)
#pragma unroll
            for (int m = 0; m < 4; ++m) { const int row = row0 + ai * 128 + m * 16; const float sc = scv[ai][m]; bf16* rowp = O + (size_t)row * ldc + col0;
#pragma unroll
                for (int bj = 0; bj < 2; ++bj) { const f32x4 v0 = acc[ai][bj][m][0] * sc, v1 = acc[ai][bj][m][1] * sc;
                    pg8::u32x4 w; w.x = cvt_pk_bf16(v0[0], v0[1]); w.y = cvt_pk_bf16(v0[2], v0[3]); w.z = cvt_pk_bf16(v1[0], v1[1]); w.w = cvt_pk_bf16(v1[2], v1[3]);
                    *(pg8::u32x4*)(rowp + bj * 128) = w; } }
    }
};
struct EpiPool {
    static constexpr bool PERM = true, CHAIN = false; static constexpr int NST = 16;
    bf16* BR; const float* bp; const float* sp;
    __device__ __forceinline__ void operator()(const f32x4 (&acc)[2][2][4][2], const Unit& u, int wr, int wc, int fr, int fq) const {
        const int row0 = u.pm * 256 + wr * 64 + fr, col0 = u.pn * 256 + wc * 32 + 8 * fq;
        f32x4 bv[2][2], sv[2][2];
#pragma unroll
        for (int bj = 0; bj < 2; ++bj)
#pragma unroll
            for (int n = 0; n < 2; ++n) { bv[bj][n] = *(const f32x4*)(bp + col0 + bj * 128 + 4 * n); sv[bj][n] = *(const f32x4*)(sp + col0 + bj * 128 + 4 * n); }
#pragma unroll
        for (int ai = 0; ai < 2; ++ai)
#pragma unroll
            for (int m = 0; m < 4; ++m) { const int row = row0 + ai * 128 + m * 16; bf16* rowp = BR + (size_t)row * BRW + 2048 + col0;
#pragma unroll
                for (int bj = 0; bj < 2; ++bj) { const f32x4 v0 = (acc[ai][bj][m][0] + bv[bj][0]) * sv[bj][0], v1 = (acc[ai][bj][m][1] + bv[bj][1]) * sv[bj][1];
                    pg8::u32x4 w; w.x = cvt_pk_bf16(v0[0], v0[1]); w.y = cvt_pk_bf16(v0[2], v0[3]); w.z = cvt_pk_bf16(v1[0], v1[1]); w.w = cvt_pk_bf16(v1[2], v1[3]);
                    *(pg8::u32x4*)(rowp + bj * 128) = w; } }
    }
};
template <bool FIRST> struct EpiMerge {
    static constexpr bool PERM = true, CHAIN = false; static constexpr int NST = 16;
    bf16* MG; const bf16* Zg;
    __device__ __forceinline__ void operator()(const f32x4 (&acc)[2][2][4][2], const Unit& u, int wr, int wc, int fr, int fq) const {
        const int row0 = u.pm * 256 + wr * 64 + fr, col0 = u.pn * 256 + wc * 32 + 8 * fq;
#pragma unroll
        for (int ai = 0; ai < 2; ++ai)
#pragma unroll
            for (int m = 0; m < 4; ++m) { const int row = row0 + ai * 128 + m * 16; bf16* rowp = MG + (size_t)row * DM + col0; const bf16* gp = Zg + (size_t)row * ZW + col0;
#pragma unroll
                for (int bj = 0; bj < 2; ++bj) { const pg8::u32x4 gq = *(const pg8::u32x4*)(gp + bj * 128);
                    f32x4 v0 = acc[ai][bj][m][0], v1 = acc[ai][bj][m][1];
                    v0[0] *= bflo(gq.x); v0[1] *= bfhi(gq.x); v0[2] *= bflo(gq.y); v0[3] *= bfhi(gq.y); v1[0] *= bflo(gq.z); v1[1] *= bfhi(gq.z); v1[2] *= bflo(gq.w); v1[3] *= bfhi(gq.w);
                    if (!FIRST) { const pg8::u32x4 oq = *(const pg8::u32x4*)(rowp + bj * 128);
                        v0[0] += bflo(oq.x); v0[1] += bfhi(oq.x); v0[2] += bflo(oq.y); v0[3] += bfhi(oq.y); v1[0] += bflo(oq.z); v1[1] += bfhi(oq.z); v1[2] += bflo(oq.w); v1[3] += bfhi(oq.w); }
                    pg8::u32x4 w; w.x = cvt_pk_bf16(v0[0], v0[1]); w.y = cvt_pk_bf16(v0[2], v0[3]); w.z = cvt_pk_bf16(v1[0], v1[1]); w.w = cvt_pk_bf16(v1[2], v1[3]);
                    *(pg8::u32x4*)(rowp + bj * 128) = w; } }
    }
};
struct EpiMergeH {
    static constexpr bool PERM = true, CHAIN = true; static constexpr int NST = 0;
    bf16* MG; const bf16* Zg;
    __device__ __forceinline__ bool chain(f32x4 (&acc)[2][2][4][2], const Unit& u, int wr, int wc, int fr, int fq) const {
        const int row0 = u.pm * 256 + wr * 64 + fr, col0 = u.pn * 256 + wc * 32 + 8 * fq, br = u.kofs >> 11;
#pragma unroll
        for (int ai = 0; ai < 2; ++ai) {
            v2u gq[4][2], hq[4][2];
#pragma unroll
            for (int m = 0; m < 4; ++m) { const unsigned char* gp = (const unsigned char*)Zg + (size_t)(row0 + ai * 128 + m * 16) * (ZW * 2) + col0 + br * 2048;
#pragma unroll
                for (int bj = 0; bj < 2; ++bj) { gq[m][bj] = *(const v2u*)(gp + bj * 128); if (br < 2) hq[m][bj] = *(const v2u*)(gp + 2048 + bj * 128); else hq[m][bj] = (v2u){0u, 0u}; } }
#pragma unroll
            for (int m = 0; m < 4; ++m) { const int row = row0 + ai * 128 + m * 16;
#pragma unroll
                for (int bj = 0; bj < 2; ++bj) { const v2u g_ = gq[m][bj], h_ = hq[m][bj];
                    float f[8] = {(float)(g_.x & 255u), (float)((g_.x >> 8) & 255u), (float)((g_.x >> 16) & 255u), (float)(g_.x >> 24), (float)(g_.y & 255u), (float)((g_.y >> 8) & 255u), (float)((g_.y >> 16) & 255u), (float)(g_.y >> 24)};
                    if (br < 2) {
                        const float d[8] = {(float)(h_.x & 255u), (float)((h_.x >> 8) & 255u), (float)((h_.x >> 16) & 255u), (float)(h_.x >> 24), (float)(h_.y & 255u), (float)((h_.y >> 8) & 255u), (float)((h_.y >> 16) & 255u), (float)(h_.y >> 24)};
#pragma unroll
                        for (int j = 0; j < 8; ++j) f[j] = f[j] * __builtin_amdgcn_rcpf(fmaxf(d[j], 0.5f)); }
                    else {
#pragma unroll
                        for (int j = 0; j < 8; ++j) f[j] *= (1.f / 255.f); }
#pragma unroll
                    for (int j = 0; j < 4; ++j) { acc[ai][bj][m][0][j] *= f[j]; acc[ai][bj][m][1][j] *= f[4 + j]; }
                    if (br == 2) { const f32x4 v0 = acc[ai][bj][m][0], v1 = acc[ai][bj][m][1];
                        pg8::u32x4 w; w.x = cvt_pk_bf16(v0[0], v0[1]); w.y = cvt_pk_bf16(v0[2], v0[3]); w.z = cvt_pk_bf16(v1[0], v1[1]); w.w = cvt_pk_bf16(v1[2], v1[3]);
                        *(pg8::u32x4*)(MG + (size_t)row * DM + col0 + bj * 128) = w; } } }
            asm volatile("" ::: "memory");
        }
        return br < 2;
    }
};
template <bool INBF, bool OUTBF> struct EpiResid {
    static constexpr bool PERM = INBF && OUTBF, CHAIN = false;
    static constexpr int NST = (INBF && OUTBF) ? 16 : 32;
    const void* xin; void* xout; const float* gate;
    __device__ __forceinline__ void operator()(const f32x4 (&acc)[2][2][4][2], const Unit& u, int wr, int wc, int fr, int fq) const {
        const int row0 = u.pm * 256 + wr * 64 + fr;
        if (PERM) {
            const int col0 = u.pn * 256 + wc * 32 + 8 * fq; const float* gb = gate + (size_t)(u.pm >> 3) * ADA + col0;
            f32x4 gv[2][2];
#pragma unroll
            for (int bj = 0; bj < 2; ++bj)
#pragma unroll
                for (int n = 0; n < 2; ++n) gv[bj][n] = *(const f32x4*)(gb + bj * 128 + n * 4);
#pragma unroll
            for (int ai = 0; ai < 2; ++ai) { pg8::u32x4 xq[4][2];
#pragma unroll
                for (int m = 0; m < 4; ++m)
#pragma unroll
                    for (int bj = 0; bj < 2; ++bj) xq[m][bj] = *(const pg8::u32x4*)((const bf16*)xin + (size_t)(row0 + ai * 128 + m * 16) * DM + col0 + bj * 128);
#pragma unroll
                for (int m = 0; m < 4; ++m) { const size_t off = (size_t)(row0 + ai * 128 + m * 16) * DM + col0;
#pragma unroll
                    for (int bj = 0; bj < 2; ++bj) {
                        const f32x4 v0 = gv[bj][0] * acc[ai][bj][m][0], v1 = gv[bj][1] * acc[ai][bj][m][1];
                        pg8::u32x4 w; w.x = cvt_pk_bf16(bflo(xq[m][bj].x) + v0[0], bfhi(xq[m][bj].x) + v0[1]); w.y = cvt_pk_bf16(bflo(xq[m][bj].y) + v0[2], bfhi(xq[m][bj].y) + v0[3]);
                        w.z = cvt_pk_bf16(bflo(xq[m][bj].z) + v1[0], bfhi(xq[m][bj].z) + v1[1]); w.w = cvt_pk_bf16(bflo(xq[m][bj].w) + v1[2], bfhi(xq[m][bj].w) + v1[3]);
                        *(pg8::u32x4*)((bf16*)xout + off + bj * 128) = w; } }
                asm volatile("" ::: "memory"); }
        } else {
            const int col0 = u.pn * 256 + wc * 32 + 4 * fq; const float* gb = gate + (size_t)(u.pm >> 3) * ADA + col0;
            f32x4 gv[2][2];
#pragma unroll
            for (int bj = 0; bj < 2; ++bj)
#pragma unroll
                for (int n = 0; n < 2; ++n) gv[bj][n] = *(const f32x4*)(gb + bj * 128 + n * 16);
#pragma unroll
            for (int ai = 0; ai < 2; ++ai)
#pragma unroll
                for (int mp = 0; mp < 2; ++mp) { f32x4 xv[2][2][2];
#pragma unroll
                    for (int mm = 0; mm < 2; ++mm) { const size_t off = (size_t)(row0 + ai * 128 + (2 * mp + mm) * 16) * DM + col0;
#pragma unroll
                        for (int bj = 0; bj < 2; ++bj)
#pragma unroll
                            for (int n = 0; n < 2; ++n) {
                                if (INBF) { const v2u xq = *(const v2u*)((const bf16*)xin + off + bj * 128 + n * 16); xv[mm][bj][n] = (f32x4){bflo(xq.x), bfhi(xq.x), bflo(xq.y), bfhi(xq.y)}; }
                                else xv[mm][bj][n] = *(const f32x4*)((const float*)xin + off + bj * 128 + n * 16); } }
#pragma unroll
                    for (int mm = 0; mm < 2; ++mm) { const int m = 2 * mp + mm; const size_t off = (size_t)(row0 + ai * 128 + m * 16) * DM + col0;
#pragma unroll
                        for (int bj = 0; bj < 2; ++bj)
#pragma unroll
                            for (int n = 0; n < 2; ++n) {
                                const f32x4 r = xv[mm][bj][n] + gv[bj][n] * acc[ai][bj][m][n];
                                if (OUTBF) { v2u w; w.x = cvt_pk_bf16(r[0], r[1]); w.y = cvt_pk_bf16(r[2], r[3]); *(v2u*)((bf16*)xout + off + bj * 128 + n * 16) = w; }
                                else *(f32x4*)((float*)xout + off + bj * 128 + n * 16) = r; } }
                    asm volatile("" ::: "memory"); }
        }
    }
};
struct EpiSwiglu {
    static constexpr bool PERM = true, CHAIN = false; static constexpr int NST = 8;
    bf16* ACT;
    __device__ __forceinline__ void operator()(const f32x4 (&acc)[2][2][4][2], const Unit& u, int wr, int wc, int fr, int fq) const {
        const int row0 = u.pm * 256 + wr * 64 + fr, col0 = u.pn * 128 + wc * 32 + 8 * fq;
#pragma unroll
        for (int ai = 0; ai < 2; ++ai)
#pragma unroll
            for (int m = 0; m < 4; ++m) { bf16* rowp = ACT + (size_t)(row0 + ai * 128 + m * 16) * FF + col0;
                f32x4 v0, v1;
#pragma unroll
                for (int j = 0; j < 4; ++j) { const float g0 = acc[ai][0][m][0][j], g1 = acc[ai][0][m][1][j]; v0[j] = g0 * sigmoidf_(g0) * acc[ai][1][m][0][j]; v1[j] = g1 * sigmoidf_(g1) * acc[ai][1][m][1][j]; }
                pg8::u32x4 w; w.x = cvt_pk_bf16(v0[0], v0[1]); w.y = cvt_pk_bf16(v0[2], v0[3]); w.z = cvt_pk_bf16(v1[0], v1[1]); w.w = cvt_pk_bf16(v1[2], v1[3]);
                *(pg8::u32x4*)rowp = w; }
    }
};

constexpr int NP = 12;
constexpr int NGP = 2 + DEPTH * NP;
__global__ void __launch_bounds__(NWAVES * 64, 2) hybrid_fwd(Args args_unused) {
    extern __shared__ __attribute__((aligned(16))) unsigned char lds[];
    Frame F;
    F.lds = (LAS unsigned char*)lds;
    F.tid = threadIdx.x; F.lane = F.tid & 63; F.wave = __builtin_amdgcn_readfirstlane(F.tid >> 6);
    F.G = gridDim.x; F.gw = blockIdx.x * NWAVES + F.wave; F.NGW = F.G * NWAVES;
    volatile LAS unsigned* MISC = (volatile LAS unsigned*)(F.lds + MISC_OFF);
    for (int u = F.tid; u < (LDS_BYTES - LDSCTL_OFF) / 4; u += NWAVES * 64) ((LAS unsigned*)(F.lds + LDSCTL_OFF))[u] = 0u;
    __syncthreads();
    KArgs ka0 = (KArgs)__builtin_amdgcn_kernarg_segment_ptr();
    const int lo = ka0->gp_lo, hi = ka0->gp_hi;
    XcdBarrier bar; bar.bar = (unsigned*)(ka0->ws + WS_CTL) + CW_BAR; bar.x = 0; bar.st = nullptr; bar.wave = F.wave;
    if (hi - lo > 1) bar = xcd_barrier_post((unsigned*)(ka0->ws + WS_CTL) + CW_BAR, MISC + 8, F.wave);
    F.cid = blockIdx.x;
#define IN(k) (lo <= (k) && (k) < hi && relaunder(F))
#define KA() KArgs a = ka0; asm volatile("" : "+s"(a)); unsigned char* ws = a->ws; LAS unsigned char* ring = F.lds
#define SEAM(k) do { if ((k) + 1 < hi) xcd_barrier(bar); } while (0)

    if (IN(0)) { KA(); (void)ws; (void)ring; adaln_partials(F, a); rope_table(F, a); SEAM(0);
        if (hi > 1) {
            if (F.tid == 0) { unsigned* bw = (unsigned*)(ws + WS_CTL) + CW_BAR; bool even = (F.G % 8 == 0); int nxcc = 0;
                for (int j = 0; j < 16; ++j) { const unsigned c = xb_ld(&bw[XB_XCNT(j)]); if (c) { ++nxcc; if (c != (unsigned)(F.G / 8)) even = false; } }
                const unsigned x = xb_xcc_id(), rk = MISC[10];
                MISC[11] = (even && nxcc == 8 && x < 8u) ? rk * 8u + x : (unsigned)blockIdx.x; }
            __syncthreads();
            F.cid = (int)__builtin_amdgcn_readfirstlane(MISC[11]);
        } }
    if (IN(1)) { KA(); (void)ws; (void)ring; adaln_reduce(F, a); SEAM(1); }

    for (int l = 0; l < DEPTH; ++l) {
        const int g0 = 2 + l * NP;
        if (IN(g0 + 0)) { KA(); (void)ring;
#pragma unroll 1
            for (int rep = 0; rep < REP_THIN; ++rep) { convert_weights(F, a, l); __syncthreads();
            if (l == 0) norm_rows<false, true>(F, a->x, a->g_norm1 + l * DM, (const float*)(ws + WS_MOD) + (size_t)l * 8 * ADA, 0, 1, (bf16*)(ws + WS_H), ws + WS_H8);
            else norm_rows<true, true>(F, ws + WS_XB, a->g_norm1 + l * DM, (const float*)(ws + WS_MOD) + (size_t)l * 8 * ADA, 0, 1, (bf16*)(ws + WS_H), ws + WS_H8); }
            SEAM(g0 + 0); }
        if (IN(g0 + 1)) { KA();
            { pg8::Gemm g{(const bf16*)(ws + WS_H), (const bf16*)(ws + WS_WIN), M, NZB * 256, DM, DM, DM, 0}; pg8::SkipOrder S; S.init(M, NZB * 256, F.G, F.cid); S.lo = ZO / 256; S.gap = NZO;
              EpiZ E{(bf16*)(ws + WS_Z), (float*)(ws + WS_IF)};
              pg8::gemm_phase<EpiZ, pg8::SkipOrder>(ring, g, S, E, F.tid); }
            relaunder(F);
            { pg8::Gemm g{(const bf16*)(ws + WS_H8), (const bf16*)(ws + WS_W8), M, NZG * 256, DM / 2, DM / 2, DM / 2, 0}; pg8::StaticOrder S; S.init(M, NZG * 256, F.G, F.cid);
              EpiZG E{(bf16*)(ws + WS_Z)};
              pg8::gemm_phase<EpiZG, pg8::StaticOrder, true, true>(ring, g, S, E, F.tid); }
            SEAM(g0 + 1);
        }
        if (IN(g0 + 2)) { KA(); (void)ws; (void)ring;
#pragma unroll 1
            for (int rep = 0; rep < REP_THIN; ++rep) {
                if (F.G > 64) {
                    if (blockIdx.x < 32) prep_mlstm(F, a, l);
                    else { Frame F2 = F; F2.gw = F.gw - 32 * NWAVES; F2.NGW = F.NGW - 32 * NWAVES; prep_pooled(F2, a); prep_rstd(F2, a); }
                } else { prep_pooled(F, a); prep_rstd(F, a); prep_mlstm(F, a, l); } }
            SEAM(g0 + 2); }
        if (IN(g0 + 3)) { KA();
            bf16* Z = (bf16*)(ws + WS_Z); bf16* BR = (bf16*)(ws + WS_BR);
            { pg8::Gemm g{Z + ZQL, (const bf16*)(ws + WS_WUQ), M, QW, 512, ZW, 512, 0}; pg8::StaticOrder S; S.init(M, QW, F.G, F.cid);
              EpiRowScale E{(bf16*)(ws + WS_QRAW), QW, (const float*)(ws + WS_RSTD), 0}; pg8::gemm_phase<EpiRowScale, pg8::StaticOrder>(ring, g, S, E, F.tid); }
            relaunder(F);
            { pg8::Gemm g{Z + ZKVL, (const bf16*)(ws + WS_WUKV), M, KVW, 256, ZW, 256, 0}; pg8::StaticOrder S; S.init(M, KVW, F.G, F.cid);
              EpiRowScale E{(bf16*)(ws + WS_KVRAW), KVW, (const float*)(ws + WS_RSTD), 1}; pg8::gemm_phase<EpiRowScale, pg8::StaticOrder>(ring, g, S, E, F.tid); }
            relaunder(F);
            { pg8::Gemm g{BR, (const bf16*)(ws + WS_WPOOL), M, 1024, 256, BRW, 256, 512}; pg8::StaticOrder S;
              if (F.G == 256) S.init(M, 1024, 128, F.cid >= 128 ? F.cid - 128 : (1 << 20)); else S.init(M, 1024, F.G, F.cid);
              EpiPool E{BR, a->b_pool + l * 1024, a->s_pool + l * 1024}; pg8::gemm_phase<EpiPool, pg8::StaticOrder>(ring, g, S, E, F.tid); }
#if FA_MLSTM && ML_CHUNKED
            relaunder(F); fa::dstate_phase(F, a);
#endif
            SEAM(g0 + 3);
        }
        if (IN(g0 + 4)) { KA(); (void)ws; (void)ring; kstats(F, a, l);
#if FA_MLSTM && ML_CHUNKED
            relaunder(F); fa::dstate_scan(F, a);
#endif
            SEAM(g0 + 4); }
#if FA_MLA
        if (IN(g0 + 5)) { KA(); (void)ws; (void)ring;
#pragma unroll 1
            for (int rep = 0; rep < REP_ATT; ++rep) { fa::phase<0>(F, a, l); relaunder(F); fa::phase<1>(F, a, l); }
            SEAM(g0 + 5); }
#endif
        if (IN(g0 + 7)) { KA();
            bf16* Z = (bf16*)(ws + WS_Z); bf16* BR = (bf16*)(ws + WS_BR); bf16* MG = (bf16*)(ws + WS_MERGED); const bf16* WB = (const bf16*)(ws + WS_WBR);
            pg8::SegOrder<3> S; S.init(M, DM, F.G, F.cid); S.seg_bytes = 2048;
            { pg8::Gemm g{BR, WB, M, DM, 1024, BRW, 3072, 0}; EpiMergeH E{MG, Z + ZG}; pg8::gemm_phase<EpiMergeH, pg8::SegOrder<3>>(ring, g, S, E, F.tid); }
            SEAM(g0 + 7);
        }
        if (IN(g0 + 8)) { KA();
            pg8::Gemm g{(const bf16*)(ws + WS_MERGED), (const bf16*)(ws + WS_WOUT), M, DM, DM, DM, DM, 0}; pg8::StaticOrder S; S.init(M, DM, F.G, F.cid);
            const float* gate = (const float*)(ws + WS_MOD) + (size_t)l * 8 * ADA + 2 * DM;
            if (l == 0) { EpiResid<false, true> E{a->x, ws + WS_XB, gate}; pg8::gemm_phase<EpiResid<false, true>, pg8::StaticOrder>(ring, g, S, E, F.tid); }
            else { relaunder(F); EpiResid<true, true> E{ws + WS_XB, ws + WS_XB, gate}; pg8::gemm_phase<EpiResid<true, true>, pg8::StaticOrder>(ring, g, S, E, F.tid); }
            SEAM(g0 + 8);
        }
        if (IN(g0 + 9)) { KA(); (void)ring;
#pragma unroll 1
            for (int rep = 0; rep < REP_THIN; ++rep) norm_rows<true>(F, ws + WS_XB, a->g_norm2 + l * DM, (const float*)(ws + WS_MOD) + (size_t)l * 8 * ADA, 3, 4, (bf16*)(ws + WS_H));
            SEAM(g0 + 9); }
        if (IN(g0 + 10)) { KA();
            pg8::Gemm g{(const bf16*)(ws + WS_H), (const bf16*)(ws + WS_WFFI), M, 2 * FF, DM, DM, DM, 0}; pg8::StaticOrder S; S.init(M, 2 * FF, F.G, F.cid);
            EpiSwiglu E{(bf16*)(ws + WS_Z)};
            pg8::gemm_phase<EpiSwiglu, pg8::StaticOrder>(ring, g, S, E, F.tid);
            if (REP_G > 1) { relaunder(F); pg8::gemm_phase<EpiSwiglu, pg8::StaticOrder>(ring, g, S, E, F.tid); }
            SEAM(g0 + 10);
        }
        if (IN(g0 + 11)) { KA();
            pg8::Gemm g{(const bf16*)(ws + WS_Z), (const bf16*)(ws + WS_WFFO), M, DM, FF, FF, FF, 0}; pg8::StaticOrder S; S.init(M, DM, F.G, F.cid);
            const float* gate = (const float*)(ws + WS_MOD) + (size_t)l * 8 * ADA + 5 * DM;
            if (l + 1 < DEPTH) { EpiResid<true, true> E{ws + WS_XB, ws + WS_XB, gate}; pg8::gemm_phase<EpiResid<true, true>, pg8::StaticOrder>(ring, g, S, E, F.tid); }
            else { relaunder(F); EpiResid<true, false> E{ws + WS_XB, a->out, gate}; pg8::gemm_phase<EpiResid<true, false>, pg8::StaticOrder>(ring, g, S, E, F.tid); }
            SEAM(g0 + 11);
        }
    }
#undef IN
#undef KA
#undef SEAM
}

extern "C" void kernel_launch(void* const* d_in, const int* in_sizes, int n_in, void* d_out, int out_size, void* d_ws, size_t ws_size, hipStream_t stream) {
    static int grid = 0;
    if (grid == 0) {
        if (n_in != 22 || in_sizes[0] != M * DM || out_size != M * DM || ws_size < WS_END) { fprintf(stderr, "kernel_launch: unexpected shapes (n_in %d, in0 %d, out %d, ws %zu); nothing launched\n", n_in, n_in > 0 ? in_sizes[0] : -1, out_size, ws_size); grid = -1; return; }
        int dev = 0, cus = 0, per_cu = 0;
        if (hipGetDevice(&dev) != hipSuccess || hipDeviceGetAttribute(&cus, hipDeviceAttributeMultiprocessorCount, dev) != hipSuccess) { grid = -1; return; }
        if (hipFuncSetAttribute((const void*)hybrid_fwd, hipFuncAttributeMaxDynamicSharedMemorySize, LDS_BYTES) != hipSuccess) { fprintf(stderr, "kernel_launch: hipFuncSetAttribute failed\n"); grid = -1; return; }
        if (hipOccupancyMaxActiveBlocksPerMultiprocessor(&per_cu, (const void*)hybrid_fwd, NWAVES * 64, LDS_BYTES) != hipSuccess || per_cu < 1) { fprintf(stderr, "kernel_launch: occupancy query reports %d\n", per_cu); }
        (void)hipGetLastError();
        grid = cus;
    }
    if (grid < 0) return;
    (void)hipMemsetAsync((char*)d_ws + WS_CTL, 0, CTL_ZERO_BYTES, stream);
    Args a{};
    const float** ap = (const float**)&a;
    for (int i = 0; i < 22; ++i) ap[i] = (const float*)d_in[i];
    a.out = (float*)d_out; a.ws = (unsigned char*)d_ws;
#if MK_PER_PHASE
    for (int gp = 0; gp < NGP; ++gp) { a.gp_lo = gp; a.gp_hi = gp + 1; hipLaunchKernelGGL(hybrid_fwd, dim3(grid), dim3(NWAVES * 64), LDS_BYTES, stream, a); }
#else
    a.gp_lo = 0; a.gp_hi = NGP; hipLaunchKernelGGL(hybrid_fwd, dim3(grid), dim3(NWAVES * 64), LDS_BYTES, stream, a);
#endif
}
```

```cpp
#include <hip/hip_runtime.h>
#include <cstdio>
#include <cstdint>

#ifndef FA_MLA
#define FA_MLA 1
#endif
#ifndef FA_MLSTM
#define FA_MLSTM 1
#endif
#ifndef REP_THIN
#define REP_THIN 1
#endif
#ifndef REP_ATT
#define REP_ATT 1
#endif
#ifndef REP_G
#define REP_G 1
#endif
#ifndef ML_CHUNKED
#define ML_CHUNKED 1
#endif
#ifndef MK_PER_PHASE
#define MK_PER_PHASE 0
#endif

constexpr int H8_LOG2 = 5, W8_LOG2 = 11;
namespace pg8 {
#define PG8_LAS __attribute__((address_space(3)))
typedef unsigned short bf16_t;
typedef short bf16x8 __attribute__((ext_vector_type(8)));
typedef float f32x4 __attribute__((ext_vector_type(4)));
typedef unsigned u32x4 __attribute__((ext_vector_type(4)));
typedef int i32x4 __attribute__((ext_vector_type(4)));
constexpr int BM = 256, BK = 64, HALF = 128, HTB = HALF * BK * 2  , STAGE_BYTES = 8 * HTB, NXCD = 8, WGM = 8;

__host__ __device__ __forceinline__ int lds_byte(int r, int c) { const int st = (r >> 4) * 2 + (c >> 5), rr = r & 15, cc = c & 31, ob = rr * 64 + cc * 2; return st * 1024 + (ob ^ (((ob >> 9) & 1) << 5)); }
__host__ __device__ __forceinline__ void stage_rc(int b, int& R, int& C) { const int st = b / 1024, sb = b % 1024, swz = sb ^ (((sb >> 9) & 1) << 5); R = (st >> 1) * 16 + swz / 64; C = (st & 1) * 32 + (swz % 64) / 2; }
__host__ __device__ __forceinline__ int perm32(int rho) { const int n = rho >> 4, i = rho & 15; return 8 * (i >> 2) + 4 * n + (i & 3); }

struct Unit { int pm, pn, kofs; };
struct Gemm { const bf16_t* A; const bf16_t* Bt; int M, N, K, lda, ldb, a_pn_step; };

struct StaticOrder {
    int nM, nN, nwg, G, c;
    __host__ __device__ void init(int M, int N, int G_, int c_) { nM = M / BM; nN = N / BM; nwg = nM * nN; G = G_; c = c_; }
    __host__ __device__ bool next(int i, Unit& u) const {
        const long L = (long)i * G + c; if (L >= nwg) return false;
        int wgid = (int)L; { const int q = nwg / NXCD, r = nwg % NXCD, xcd = wgid % NXCD, off = wgid / NXCD; wgid = (xcd < r ? xcd * (q + 1) : r * (q + 1) + (xcd - r) * q) + off; }
        const int nig = WGM * nN, gid = wgid / nig, fm = gid * WGM, gsz = (nM - fm) < WGM ? (nM - fm) : WGM;
        u.pm = fm + ((wgid % nig) % gsz); u.pn = (wgid % nig) / gsz; u.kofs = 0; return true;
    }
    __device__ __forceinline__ void a_ready(const Unit&) const {}
    __device__ __forceinline__ void done(const Unit&) const {}
};
struct SkipOrder : StaticOrder {
    int lo, gap;
    __host__ __device__ bool next(int i, Unit& u) const { if (!StaticOrder::next(i, u)) return false; if (u.pn >= lo) u.pn += gap; return true; }
};
template <int NSEG> struct SegOrder : StaticOrder {
    int seg_bytes;
    __host__ __device__ bool next(int i, Unit& u) const { if (!StaticOrder::next(i / NSEG, u)) return false; u.kofs = (i % NSEG) * seg_bytes; return true; }
};

__device__ __forceinline__ unsigned cvt_pk_bf16(float lo, float hi) { unsigned r; asm volatile("v_cvt_pk_bf16_f32 %0, %1, %2" : "=v"(r) : "v"(lo), "v"(hi)); return r; }

template <class Epi, class Sched, bool ALIGN_EPI = true, bool F8 = false>
__device__ __forceinline__ void gemm_phase(PG8_LAS unsigned char* lds, const Gemm g, const Sched& S, const Epi& E, const int tid) {
    const int wid = __builtin_amdgcn_readfirstlane(tid >> 6), lane = tid & 63, wr = wid >> 2, wc = wid & 3, fr = lane & 15, fq = lane >> 4;
    int K_ = g.K; asm volatile("" : "+s"(K_));
    const int K = K_, nt = K / BK;
    unsigned voffA[2], voffB[2];
#pragma unroll
    for (int i = 0; i < 2; ++i) { int R, C; stage_rc(tid * 16 + i * 8192, R, C); const int Rb = Epi::PERM ? ((R & ~31) + perm32(R & 31)) : R;
        voffA[i] = (unsigned)(R * g.lda + C) * 2u; voffB[i] = (unsigned)(Rb * g.ldb + C) * 2u; }
    const size_t kstep = (size_t)(BK * 2);
    const size_t hstepA = (size_t)HALF * g.lda * 2, hstepB = (size_t)HALF * g.ldb * 2;
    const size_t tstepA = 2 * hstepA, tstepB = 2 * hstepB;
    const unsigned ldsw = (unsigned)wid * 1024u;
    const unsigned ldsb = (unsigned)__builtin_amdgcn_readfirstlane((int)((unsigned)(uintptr_t)lds + ldsw));
    int f8sw = 127 - W8_LOG2, f8sh = 127 - H8_LOG2; if constexpr (F8) { asm volatile("" : "+v"(f8sw), "+v"(f8sh)); }
    const int aoff = lds_byte(wr * 64 + fr, fq * 8), boff = lds_byte(wc * 32 + fr, fq * 8);
#define PG8_SA(b, h) (((b) * 2 + (h)) * HTB)
#define PG8_SB(b, h) ((4 + (b) * 2 + (h)) * HTB)
#define PG8_STAGE(bufoff, gbase, voff) do { _Pragma("unroll") for (int _i = 0; _i < 2; ++_i) { const unsigned m0v_ = ldsb + (unsigned)((bufoff) + _i * 8192); \
        asm volatile("s_nop 4\n\ts_mov_b32 m0, %0\n\ts_nop 0\n\tglobal_load_lds_dwordx4 %1, %2" :: "s"(m0v_), "v"((voff)[_i]), "s"((const char*)(gbase)) : "memory", "m0"); } } while (0)
#define PG8_LDA(dst, b, h) do { _Pragma("unroll") for (int m = 0; m < 4; ++m) _Pragma("unroll") for (int k = 0; k < 2; ++k) dst[m][k] = *(const PG8_LAS bf16x8*)(lds + PG8_SA(b, h) + aoff + m * 2048 + k * 1024); } while (0)
#define PG8_LDB(dst, b, h) do { _Pragma("unroll") for (int n = 0; n < 2; ++n) _Pragma("unroll") for (int k = 0; k < 2; ++k) dst[n][k] = *(const PG8_LAS bf16x8*)(lds + PG8_SB(b, h) + boff + n * 2048 + k * 1024); } while (0)
#define PG8_CAT8(x0, x1) __builtin_shufflevector(__builtin_bit_cast(i32x4, x0), __builtin_bit_cast(i32x4, x1), 0, 1, 2, 3, 4, 5, 6, 7)
#define PG8_MMA(ai, bj, At, Bt) do { __builtin_amdgcn_s_setprio(1); \
        if constexpr (F8) {        \
            _Pragma("unroll") for (int m = 0; m < 4; ++m) _Pragma("unroll") for (int n = 0; n < 2; ++n) \
            asm volatile("s_nop 1\n\tv_mfma_scale_f32_16x16x128_f8f6f4 %0, %1, %2, %0, %3, %4 op_sel_hi:[0,0,0]" : "+v"(acc[ai][bj][m][n]) : "v"(PG8_CAT8(Bt[n][0], Bt[n][1])), "v"(PG8_CAT8(At[m][0], At[m][1])), "v"(f8sw), "v"(f8sh)); } \
        else { _Pragma("unroll") for (int m = 0; m < 4; ++m) _Pragma("unroll") for (int n = 0; n < 2; ++n) _Pragma("unroll") for (int k = 0; k < 2; ++k) \
            acc[ai][bj][m][n] = __builtin_amdgcn_mfma_f32_16x16x32_bf16(Bt[n][k], At[m][k], acc[ai][bj][m][n], 0, 0, 0); } __builtin_amdgcn_s_setprio(0); } while (0)
#define PG8_WAIT_V(n) asm volatile("s_waitcnt vmcnt(" #n ")" ::: "memory")
#define PG8_WAIT_L(n) asm volatile("s_waitcnt lgkmcnt(" #n ")" ::: "memory")
#define PG8_BAR __builtin_amdgcn_s_barrier()
#define PG8_SCHED __builtin_amdgcn_sched_barrier(0)
    Unit cur, nxt; int ui = 0;
    if (!S.next(0, cur)) return;
    f32x4 acc[2][2][4][2];
#pragma unroll
    for (int a = 0; a < 2; ++a)
#pragma unroll
        for (int b = 0; b < 2; ++b)
#pragma unroll
            for (int m = 0; m < 4; ++m)
#pragma unroll
                for (int n = 0; n < 2; ++n) { acc[a][b][m][n] = (f32x4){0.f, 0.f, 0.f, 0.f}; }
    bf16x8 At[4][2], B0[2][2], B1[2][2];
    const char* cA = (const char*)g.A + (size_t)cur.pm * tstepA + (size_t)cur.pn * (size_t)g.a_pn_step + cur.kofs; const char* cB = (const char*)g.Bt + (size_t)cur.pn * tstepB + cur.kofs;
    S.a_ready(cur);
    PG8_STAGE(PG8_SB(0, 0), cB, voffB); PG8_STAGE(PG8_SB(0, 1), cB + hstepB, voffB); PG8_STAGE(PG8_SA(0, 0), cA, voffA); PG8_STAGE(PG8_SA(0, 1), cA + hstepA, voffA);
    PG8_STAGE(PG8_SB(1, 0), cB + kstep, voffB); PG8_STAGE(PG8_SA(1, 0), cA + kstep, voffA); PG8_STAGE(PG8_SB(1, 1), cB + hstepB + kstep, voffB);
    if (wr == 1) PG8_BAR;
    PG8_WAIT_V(8); PG8_BAR;
    PG8_WAIT_V(6); PG8_BAR;
    for (;;) {
        const bool has_next = S.next(ui + 1, nxt);
        const char* nA = has_next ? (const char*)g.A + (size_t)nxt.pm * tstepA + (size_t)nxt.pn * (size_t)g.a_pn_step + nxt.kofs : cA; const char* nB = has_next ? (const char*)g.Bt + (size_t)nxt.pn * tstepB + nxt.kofs : cB;
        for (int t = 0; t < nt; t += 2) {
            const bool last = (t == nt - 2);
            const char* a1 = cA + (size_t)(t + 1) * kstep;
            const char* a2 = last ? nA : cA + (size_t)(t + 2) * kstep; const char* b2 = last ? nB : cB + (size_t)(t + 2) * kstep;
            const char* a3 = a2 + kstep; const char* b3 = b2 + kstep;
            if (last && has_next) S.a_ready(nxt);
            const bool fresh = (t == 0) && (ui > 0);
#define PG8_WAIT_VF() do { if (fresh) asm volatile("s_waitcnt vmcnt(%0)" :: "i"(8 + Epi::NST) : "memory"); else PG8_WAIT_V(8); } while (0)
            PG8_LDB(B0, 0, 0); PG8_LDB(B1, 0, 1); PG8_SCHED; PG8_LDA(At, 0, 0); if (!fresh) PG8_STAGE(PG8_SA(1, 1), a1 + hstepA, voffA);
            PG8_WAIT_VF(); PG8_WAIT_L(0); PG8_BAR; PG8_MMA(0, 0, At, B0); PG8_MMA(0, 1, At, B1); PG8_BAR; PG8_SCHED;
            PG8_LDA(At, 0, 1); PG8_STAGE(PG8_SB(0, 0), b2, voffB); PG8_STAGE(PG8_SB(0, 1), b2 + hstepB, voffB); PG8_STAGE(PG8_SA(0, 0), a2, voffA);
            PG8_WAIT_VF(); PG8_WAIT_L(0); PG8_BAR; PG8_MMA(1, 0, At, B0); PG8_MMA(1, 1, At, B1); PG8_BAR; PG8_SCHED;
            PG8_LDB(B0, 1, 0); PG8_LDB(B1, 1, 1); PG8_SCHED; PG8_LDA(At, 1, 0); PG8_STAGE(PG8_SA(0, 1), a2 + hstepA, voffA);
            PG8_WAIT_VF(); PG8_WAIT_L(0); PG8_BAR; PG8_MMA(0, 0, At, B0); PG8_MMA(0, 1, At, B1); PG8_BAR; PG8_SCHED;
#undef PG8_WAIT_VF
            PG8_LDA(At, 1, 1); PG8_STAGE(PG8_SB(1, 0), b3, voffB); PG8_STAGE(PG8_SB(1, 1), b3 + hstepB, voffB); PG8_STAGE(PG8_SA(1, 0), a3, voffA);
            PG8_WAIT_V(8); PG8_WAIT_L(0); PG8_BAR; PG8_MMA(1, 0, At, B0); PG8_MMA(1, 1, At, B1); PG8_BAR; PG8_SCHED;
        }
        if constexpr (F8) asm volatile("s_nop 15\n\ts_nop 15" ::: "memory");
        if constexpr (ALIGN_EPI) { if (wr == 0) PG8_BAR; }
        if (has_next) PG8_STAGE(PG8_SA(1, 1), nA + kstep + hstepA, voffA);
        bool keep = false;
        int ln_e; asm volatile("v_mbcnt_lo_u32_b32 %0, -1, 0\n\tv_mbcnt_hi_u32_b32 %0, -1, %0" : "=v"(ln_e));
        const int fr_e = ln_e & 15, fq_e = ln_e >> 4;
        if constexpr (Epi::CHAIN) keep = E.chain(acc, cur, wr, wc, fr_e, fq_e); else E(acc, cur, wr, wc, fr_e, fq_e);
        S.done(cur);
        if (!has_next) break;
        if (!keep) {
#pragma unroll
        for (int a = 0; a < 2; ++a)
#pragma unroll
            for (int b = 0; b < 2; ++b)
#pragma unroll
                for (int m = 0; m < 4; ++m)
#pragma unroll
                    for (int n = 0; n < 2; ++n) { acc[a][b][m][n] = (f32x4){0.f, 0.f, 0.f, 0.f}; }
        }
        cur = nxt; cA = nA; cB = nB; ++ui;
        if constexpr (ALIGN_EPI) { if (wr == 1) PG8_BAR; }
    }
    PG8_WAIT_V(0);
    if constexpr (!ALIGN_EPI) { if (wr == 0) PG8_BAR; }
    PG8_BAR;
#undef PG8_SA
#undef PG8_SB
#undef PG8_STAGE
#undef PG8_LDA
#undef PG8_LDB
#undef PG8_MMA
#undef PG8_CAT8
#undef PG8_WAIT_V
#undef PG8_WAIT_L
#undef PG8_BAR
#undef PG8_SCHED
}
}

constexpr int NB = 8, SEQ = 2048, DM = 2048, M = NB * SEQ, DEPTH = 2;
constexpr int IN_W = 11080, ZW = 11264;
constexpr int ZQ = 0, ZK = 512, ZV = 1024, ZO = 2048, ZQL = 3072, ZKVL = 3584, ZKR = 3840, ZIF = 3904, ZU = 4096, ZG = 5120;
constexpr int FF = 5632, ADA = 6 * DM;
constexpr float EPS = 1e-6f;
constexpr int QW = 1536, KVW = 2048, BRW = 3072;
constexpr float LOG2E = 1.4426950408889634f;

constexpr size_t MiB = 1u << 20;
constexpr size_t WS_CTL = 0, CTL_ZERO_BYTES = 64 * 1024;
constexpr size_t WS_MOD = 1 * MiB;
constexpr size_t WS_ROPE = 2 * MiB;
constexpr size_t WS_RSTD = 2 * MiB + 512 * 1024;
constexpr size_t WS_GP = 2 * MiB + 768 * 1024;
constexpr size_t WS_IF = 3 * MiB;
constexpr size_t WS_ML = 4 * MiB;
constexpr int ML_ECH = 6 * 32 * 2048, ML_FQ = 7 * 32 * 2048, ML_FA = 8 * 32 * 2048, ML_FB = ML_FA + 512, ML_DN = 9 * 32 * 2048;
constexpr int MCH = 128, NCH = 16;
constexpr size_t WS_WIN = 8 * MiB, WS_WUQ = WS_WIN + 44 * MiB, WS_WUKV = WS_WUQ + 3 * MiB / 2, WS_WPOOL = WS_WUKV + 1 * MiB, WS_WBR = WS_WPOOL + MiB / 2,
                 WS_WOUT = WS_WBR + 12 * MiB, WS_WFFI = WS_WOUT + 8 * MiB, WS_WFFO = WS_WFFI + 44 * MiB;
constexpr size_t WS_XB = 141 * MiB;
constexpr size_t WS_Z = 205 * MiB;
constexpr size_t WS_QRAW = 557 * MiB;
constexpr size_t WS_KVRAW = 605 * MiB;
constexpr size_t WS_MERGED = WS_QRAW;
constexpr size_t WS_KF = 669 * MiB;
constexpr size_t WS_KR = WS_KF, WS_RK = WS_KF + 4 * MiB;
constexpr size_t WS_BR = 717 * MiB;
constexpr size_t WS_H8 = WS_BR + 64 * MiB;
constexpr size_t WS_W8 = WS_WIN + 20 * MiB;
constexpr int NZB = 4096 / 256, NZG = 7168 / 256;
constexpr int NZO = 1024 / 256;
constexpr size_t WS_H = WS_BR;
constexpr size_t WS_DCS = 813 * MiB;
constexpr size_t WS_END = 843 * MiB;
static_assert(WS_WFFO + 22 * MiB == WS_XB && WS_XB + 64 * MiB == WS_Z && WS_Z + 352 * MiB == WS_QRAW && WS_QRAW + 48 * MiB == WS_KVRAW && WS_KVRAW + 64 * MiB == WS_KF && WS_KF + 48 * MiB == WS_BR && WS_BR + 96 * MiB == WS_DCS && WS_DCS + 30 * MiB == WS_END, "ws map");

constexpr int CW_BAR = 4096;

constexpr int RING_BYTES = 162816, LDSCTL_OFF = RING_BYTES, MISC_OFF = LDSCTL_OFF + 320, LDS_BYTES = 163840;
constexpr int NWAVES = 8;

#define GAS __attribute__((address_space(1)))
#define LAS __attribute__((address_space(3)))
typedef unsigned short bf16;
typedef unsigned v4u __attribute__((ext_vector_type(4)));
typedef unsigned v2u __attribute__((ext_vector_type(2)));
typedef float f32x4 __attribute__((ext_vector_type(4)));
typedef float f32x2 __attribute__((ext_vector_type(2)));
#define LDS_WAIT() asm volatile("s_waitcnt lgkmcnt(0)" ::: "memory")
#define VM_WAIT() asm volatile("s_waitcnt vmcnt(0)" ::: "memory")
__device__ __forceinline__ unsigned f2bf(float f) { unsigned u = __builtin_bit_cast(unsigned, f); return (u + 0x7fffu + ((u >> 16) & 1u)) >> 16; }
__device__ __forceinline__ unsigned pk2(float lo, float hi) { return f2bf(lo) | (f2bf(hi) << 16); }
__device__ __forceinline__ unsigned pk4_fp8(float a, float b, float c, float d) {
    a = fminf(fmaxf(a, -448.f), 448.f); b = fminf(fmaxf(b, -448.f), 448.f); c = fminf(fmaxf(c, -448.f), 448.f); d = fminf(fmaxf(d, -448.f), 448.f);
    int p = 0; p = __builtin_amdgcn_cvt_pk_fp8_f32(a, b, p, false); p = __builtin_amdgcn_cvt_pk_fp8_f32(c, d, p, true); return (unsigned)p; }
__device__ __forceinline__ float bflo(unsigned w) { return __builtin_bit_cast(float, w << 16); }
__device__ __forceinline__ float bfhi(unsigned w) { return __builtin_bit_cast(float, w & 0xffff0000u); }
__device__ __forceinline__ float bf2f(bf16 b) { return __builtin_bit_cast(float, ((unsigned)b) << 16); }
__device__ __forceinline__ float sigmoidf_(float x) { return __builtin_amdgcn_rcpf(1.f + __expf(-x)); }

#define XB_TMO      128
#define XB_XCNT(j)  (256  + 64 * (j))
#define XB_XSUB(j)  (1280 + 64 * (j))
#define XB_XGEN(j)  (2304 + 64 * (j))
#define XB_TOP      3328
#define XB_TOPGEN   3392
#define XCD_BAR_WORDS 3456
#define XB_SPIN_CAP (1u << 22)
__device__ __forceinline__ unsigned xb_ld(unsigned* p)              { return __hip_atomic_load(p, __ATOMIC_RELAXED, __HIP_MEMORY_SCOPE_AGENT); }
__device__ __forceinline__ unsigned xb_add(unsigned* p, unsigned v) { return __hip_atomic_fetch_add(p, v, __ATOMIC_RELAXED, __HIP_MEMORY_SCOPE_AGENT); }
__device__ __forceinline__ unsigned xb_xcc_id() { return (unsigned)__builtin_amdgcn_s_getreg((3 << 11) | 20) & 0xFu; }
#define XB_SPIN(cond, bar) do { unsigned _sp = 0; while (cond) { __builtin_amdgcn_s_sleep(1); \
    if ((++_sp & 255u) == 0u) { if (xb_ld(&(bar)[XB_TMO])) break; if (_sp > XB_SPIN_CAP) { atomicAdd(&(bar)[XB_TMO], 1u); break; } } } } while (0)
struct XcdBarrier { unsigned* bar; unsigned x; volatile LAS unsigned* st; int wave; };
__device__ __forceinline__ bool xb_leader(int wave) { int ln; asm volatile("v_mbcnt_lo_u32_b32 %0, -1, 0\n\tv_mbcnt_hi_u32_b32 %0, -1, %0" : "=v"(ln)); return wave == 0 && ln == 0; }
__device__ __forceinline__ XcdBarrier xcd_barrier_post(unsigned* bar, volatile LAS unsigned* st, int wave) {
    XcdBarrier b; b.bar = bar; b.x = xb_xcc_id(); b.st = st; b.wave = wave;
    if (xb_leader(wave)) st[2] = xb_add(&bar[XB_XCNT(b.x)], 1u);
    return b;
}
__device__ __forceinline__ void xcd_barrier_complete(unsigned* bar, unsigned x, unsigned& nloc, unsigned& nx) {
    const unsigned G = gridDim.x * gridDim.y * gridDim.z;
    unsigned sum, cnt, mine, sp = 0u;
    for (;;) {
        sum = 0u; cnt = 0u; mine = 0u;
#pragma unroll
        for (unsigned j = 0; j < 16; ++j) { const unsigned c = xb_ld(&bar[XB_XCNT(j)]); sum += c; cnt += (c > 0u) ? 1u : 0u; mine = (j == x) ? c : mine; }
        if (sum == G) break;
        __builtin_amdgcn_s_sleep(1);
        if ((++sp & 255u) == 0u) { if (xb_ld(&bar[XB_TMO])) break; if (sp > XB_SPIN_CAP) { atomicAdd(&bar[XB_TMO], 1u); break; } }
    }
    nloc = mine > 0u ? mine : 1u; nx = cnt > 0u ? cnt : 1u;
}
__device__ __forceinline__ void xcd_barrier(const XcdBarrier& b) {
    asm volatile("s_waitcnt vmcnt(0)" ::: "memory");
    __syncthreads();
    if (xb_leader(b.wave)) {
        unsigned* bar = b.bar;
        __builtin_amdgcn_s_waitcnt(0);
        unsigned nloc = b.st[0], nx = b.st[1];
        if (nloc == 0u) { xcd_barrier_complete(bar, b.x, nloc, nx); b.st[0] = nloc; b.st[1] = nx; }
        const unsigned old = xb_add(&bar[XB_XSUB(b.x)], 1u);
        const unsigned gen = old / nloc;
        if (old + 1u == (gen + 1u) * nloc) {
            __builtin_amdgcn_fence(__ATOMIC_RELEASE, "agent");
            asm volatile("s_waitcnt vmcnt(0)" ::: "memory");
            const unsigned og = xb_add(&bar[XB_TOP], 1u);
            const unsigned tg = og / nx;
            if (og + 1u == (tg + 1u) * nx) xb_add(&bar[XB_TOPGEN], 1u);
            else XB_SPIN(xb_ld(&bar[XB_TOPGEN]) == tg, bar);
            __builtin_amdgcn_fence(__ATOMIC_ACQUIRE, "agent");
            xb_add(&bar[XB_XGEN(b.x)], 1u);
            asm volatile("s_waitcnt vmcnt(0)" ::: "memory");
        } else {
            XB_SPIN(xb_ld(&bar[XB_XGEN(b.x)]) == gen, bar);
            __builtin_amdgcn_fence(__ATOMIC_ACQUIRE, "agent");
            asm volatile("s_waitcnt vmcnt(0)" ::: "memory");
        }
    }
    __syncthreads();
}

struct Args {
    const float *x, *c, *w_ada, *b_ada, *g_norm1, *w_in, *b_mgate, *g_mnorm, *g_qlat, *w_uq, *g_kvlat, *w_ukv, *g_qn, *g_kn, *w_pool, *b_pool, *s_pool, *w_branch, *w_out, *g_norm2, *w_ffn_in, *w_ffn_out;
    float* out; unsigned char* ws; int gp_lo, gp_hi;
};
typedef const __attribute__((address_space(4))) Args* KArgs;
struct Frame {
    LAS unsigned char* lds;
    int tid, lane, wave, G, gw, NGW;
    int cid;
};
__device__ __forceinline__ bool relaunder(Frame& F) {
    int ln; asm volatile("v_mbcnt_lo_u32_b32 %0, -1, 0\n\tv_mbcnt_hi_u32_b32 %0, -1, %0" : "=v"(ln)); F.lane = ln; F.tid = F.wave * 64 + ln; return true;
}
template <int CTRL, int ROWMASK = 0xF> __device__ __forceinline__ float dppf(float old, float v) {
    return __builtin_bit_cast(float, __builtin_amdgcn_update_dpp(__builtin_bit_cast(int, old), __builtin_bit_cast(int, v), CTRL, ROWMASK, 0xF, false)); }
__device__ __forceinline__ float row16_sum(float v) {
    v += dppf<0xB1>(0.f, v); v += dppf<0x4E>(0.f, v); v += dppf<0x141>(0.f, v); v += dppf<0x140>(0.f, v); return v; }
__device__ __forceinline__ float row16_max(float v) {
    v = fmaxf(v, dppf<0xB1>(v, v)); v = fmaxf(v, dppf<0x4E>(v, v)); v = fmaxf(v, dppf<0x141>(v, v)); v = fmaxf(v, dppf<0x140>(v, v)); return v; }
__device__ __forceinline__ float wave_sum(float v) {
    v = row16_sum(v); v += dppf<0x142, 0xA>(0.f, v); v += dppf<0x143, 0xC>(0.f, v);
    return __builtin_bit_cast(float, __builtin_amdgcn_readlane(__builtin_bit_cast(int, v), 63)); }
__device__ __forceinline__ float wave_max(float v) {
    v = row16_max(v); v = fmaxf(v, dppf<0x142, 0xA>(v, v)); v = fmaxf(v, dppf<0x143, 0xC>(v, v));
    return __builtin_bit_cast(float, __builtin_amdgcn_readlane(__builtin_bit_cast(int, v), 63)); }
__device__ __forceinline__ float lane_get(float v, int src_lane) { return __builtin_bit_cast(float, __builtin_amdgcn_ds_bpermute(src_lane << 2, __builtin_bit_cast(int, v))); }
__device__ __forceinline__ float swap32(float v, int lane) {
    auto rr = __builtin_amdgcn_permlane32_swap(__float_as_uint(v), __float_as_uint(v), false, false); return __uint_as_float(lane < 32 ? rr[1] : rr[0]); }

struct MapIdent { __device__ __forceinline__ int operator()(int n) const { return n; } };
struct MapWin { __device__ __forceinline__ int operator()(int n) const {
    if (n < ZQL) return n;
    if (n < ZKVL) return 3080 + (n - ZQL);
    if (n < ZKR) return 3592 + (n - ZKVL);
    if (n < ZIF) return 3848 + (n - ZKR);
    if (n < ZIF + 8) return 3072 + (n - ZIF);
    if (n < ZU) return -1;
    if (n < ZG) return 3912 + (n - ZU);
    return 4936 + (n - ZG); } };
struct MapFfi { __device__ __forceinline__ int operator()(int n) const { const int pn = n >> 8, r = n & 255; return r < 128 ? 128 * pn + r : FF + 128 * pn + (r - 128); } };
template <class Map>
__device__ __forceinline__ void transpose_item(const float* W, int ldw, const Map& map, bf16* WT, int K, int row_off, int nblk, const float* kscale, LAS float* scr, int item, int lane) {
    const int kb = item / nblk, nb = item % nblk, k0 = 64 * kb, n0 = 32 * nb;
    const int c = map(n0 + (lane & 31));
    float vals[32];
    { const float* wp = W + (size_t)(k0 + (lane >> 5)) * ldw + (c >= 0 ? c : 0);
#pragma unroll
      for (int i = 0; i < 32; ++i) vals[i] = wp[(size_t)(2 * i) * ldw]; }
#pragma unroll
    for (int i = 0; i < 32; ++i) { const int kk = 2 * i + (lane >> 5); float v = (c >= 0) ? vals[i] : 0.f; if (kscale) v *= kscale[k0 + kk]; scr[kk * 33 + (lane & 31)] = v; }
    LDS_WAIT(); asm volatile("" ::: "memory");
    const int ch = lane & 7;
#pragma unroll
    for (int j = 0; j < 4; ++j) { const int n = (lane >> 3) + 8 * j; const LAS float* s = scr + (8 * ch) * 33 + n;
        v4u o; o.x = pk2(s[0 * 33], s[1 * 33]); o.y = pk2(s[2 * 33], s[3 * 33]); o.z = pk2(s[4 * 33], s[5 * 33]); o.w = pk2(s[6 * 33], s[7 * 33]);
        *(GAS v4u*)(WT + (size_t)(row_off + n0 + n) * K + k0 + 8 * ch) = o; }
    LDS_WAIT(); asm volatile("" ::: "memory");
}
struct CvtItem { const float* W; bf16* WT; const float* kscale; int ldw, K, row_off, kind, k0, n0; };
__device__ __forceinline__ int cvt_map(int kind, int n) { return kind == 0 ? n : (kind == 1 ? MapWin()(n) : MapFfi()(n)); }
__device__ __forceinline__ CvtItem cvt_decode(KArgs a, int l, int it) {
    unsigned char* ws = a->ws; CvtItem c; c.kscale = nullptr; c.row_off = 0; c.kind = 0; int nblk;
    constexpr int I_IN = 32 * 44, I_UQ = 8 * 6, I_UKV = 4 * 8, I_POOL = 4 * 4, I_BR = 48 * 8, I_OUT = 32 * 8, I_FFI = 32 * 44;
    int r = it;
    if (r < I_IN) { c.W = a->w_in + (size_t)l * DM * IN_W; c.ldw = IN_W; c.WT = (bf16*)(ws + WS_WIN); c.K = DM; c.kind = 1; nblk = 44; }
    else if ((r -= I_IN) < I_UQ) { c.W = a->w_uq + (size_t)l * 512 * QW; c.ldw = QW; c.WT = (bf16*)(ws + WS_WUQ); c.K = 512; c.kscale = a->g_qlat + l * 512; nblk = 6; }
    else if ((r -= I_UQ) < I_UKV) { c.W = a->w_ukv + (size_t)l * 256 * KVW; c.ldw = KVW; c.WT = (bf16*)(ws + WS_WUKV); c.K = 256; c.kscale = a->g_kvlat + l * 256; nblk = 8; }
    else if ((r -= I_UKV) < I_POOL) { const int g = r >> 2; r &= 3; c.W = a->w_pool + (size_t)(l * 4 + g) * 65536; c.ldw = 256; c.WT = (bf16*)(ws + WS_WPOOL); c.K = 256; c.row_off = g * 256; nblk = 1; }
    else if ((r -= I_POOL) < I_BR) { c.W = a->w_branch + (size_t)l * 3072 * DM; c.ldw = DM; c.WT = (bf16*)(ws + WS_WBR); c.K = 3072; nblk = 8; }
    else if ((r -= I_BR) < I_OUT) { c.W = a->w_out + (size_t)l * DM * DM; c.ldw = DM; c.WT = (bf16*)(ws + WS_WOUT); c.K = DM; nblk = 8; }
    else if ((r -= I_OUT) < I_FFI) { c.W = a->w_ffn_in + (size_t)l * DM * 2 * FF; c.ldw = 2 * FF; c.WT = (bf16*)(ws + WS_WFFI); c.K = DM; c.kind = 2; nblk = 44; }
    else { r -= I_FFI; c.W = a->w_ffn_out + (size_t)l * FF * DM; c.ldw = DM; c.WT = (bf16*)(ws + WS_WFFO); c.K = FF; nblk = 8; }
    c.k0 = 64 * (r / nblk); c.n0 = 256 * (r % nblk);
    return c;
}
__device__ __forceinline__ void convert_weights(Frame& F, KArgs a, int l) {
    constexpr int NITEMS = 32 * 44 + 8 * 6 + 4 * 8 + 4 * 4 + 48 * 8 + 32 * 8 + 32 * 44 + 88 * 8;
    constexpr int TP = 257;
    LAS float* tile = (LAS float*)F.lds;
    static_assert(2 * 64 * TP * 4 <= RING_BYTES, "transposer tiles fit the phase scratch");
    const int tid = F.tid, lr = tid >> 6, c4 = tid & 63, kg = tid & 7, nl = tid >> 3;
    const int bx = F.cid, vcu = (F.G % 8 == 0) ? (bx % 8) * (F.G / 8) + bx / 8 : bx;
    int it = vcu; asm volatile("" : "+s"(it));
#define CV_LOAD(V, D, item) do { if ((item) < NITEMS) { D = cvt_decode(a, l, (item)); const int c_ = cvt_map(D.kind, D.n0 + 4 * c4); const float* wp_ = D.W + (size_t)(D.k0 + lr) * D.ldw + (c_ >= 0 ? c_ : 0); \
        _Pragma("unroll") for (int i = 0; i < 8; ++i) { V[i] = __builtin_nontemporal_load((const f32x4*)(wp_ + (size_t)(8 * i) * D.ldw)); if (c_ < 0) V[i] = (f32x4){0.f, 0.f, 0.f, 0.f}; } } } while (0)
#define CV_STEP(V, D, bufi, item) do { if ((item) < NITEMS) { LAS float* tb = tile + (bufi) * (64 * TP); \
        _Pragma("unroll") for (int i = 0; i < 8; ++i) { LAS float* p = tb + (lr + 8 * i) * TP + 4 * c4; p[0] = V[i].x; p[1] = V[i].y; p[2] = V[i].z; p[3] = V[i].w; } \
        asm volatile("s_waitcnt lgkmcnt(0)" ::: "memory"); __builtin_amdgcn_s_barrier(); asm volatile("" ::: "memory"); \
        const CvtItem me = D; CV_LOAD(V, D, (item) + 2 * F.G); \
        float ks[8]; _Pragma("unroll") for (int j = 0; j < 8; ++j) ks[j] = me.kscale ? me.kscale[me.k0 + 8 * kg + j] : 1.f; \
        _Pragma("unroll") for (int p = 0; p < 4; ++p) { const int n = nl + 64 * p; const LAS float* sp = tb + (8 * kg) * TP + n; \
            if (me.kind == 1 && (me.n0 >= ZG || (me.n0 >= ZO && me.n0 < ZO + 1024))) { const float w8s = (float)(1 << W8_LOG2); v2u o8; const int r8 = me.n0 >= ZG ? 1024 + me.n0 - ZG : me.n0 - ZO; o8.x = pk4_fp8(sp[0] * w8s, sp[TP] * w8s, sp[2 * TP] * w8s, sp[3 * TP] * w8s); o8.y = pk4_fp8(sp[4 * TP] * w8s, sp[5 * TP] * w8s, sp[6 * TP] * w8s, sp[7 * TP] * w8s); \
                *(GAS v2u*)((unsigned char*)me.WT + 20 * MiB + (size_t)(r8 + n) * DM + me.k0 + 8 * kg) = o8; } \
            else { v4u o; o.x = pk2(sp[0] * ks[0], sp[TP] * ks[1]); o.y = pk2(sp[2 * TP] * ks[2], sp[3 * TP] * ks[3]); o.z = pk2(sp[4 * TP] * ks[4], sp[5 * TP] * ks[5]); o.w = pk2(sp[6 * TP] * ks[6], sp[7 * TP] * ks[7]); \
            *(GAS v4u*)(me.WT + (size_t)(me.row_off + me.n0 + n) * me.K + me.k0 + 8 * kg) = o; } } } } while (0)
    f32x4 vA[8], vB[8]; CvtItem dA, dB;
    CV_LOAD(vA, dA, it); CV_LOAD(vB, dB, it + F.G);
    for (; it < NITEMS; it += 2 * F.G) { CV_STEP(vA, dA, 0, it); CV_STEP(vB, dB, 1, it + F.G); }
#undef CV_LOAD
#undef CV_STEP
    asm volatile("s_waitcnt lgkmcnt(0)" ::: "memory"); __builtin_amdgcn_s_barrier(); asm volatile("" ::: "memory");
}

__device__ __forceinline__ void adaln_partials(Frame& F, KArgs a) {
    LAS float* sc = (LAS float*)(F.lds);
    float* part = (float*)(a->ws + WS_Z);
    for (int it = blockIdx.x; it < 2 * 32 * 12; it += F.G) {
        const int l = it / 384, r = it % 384, kc = r / 12, jc = r % 12;
        __syncthreads();
        { const int b = F.tid >> 6, k = F.tid & 63; const float cv = a->c[b * DM + kc * 64 + k]; sc[k * 8 + b] = cv / (1.f + expf(-cv)); }
        __syncthreads();
        const int j = jc * 1024 + 2 * F.tid;
        const float* w = a->w_ada + ((size_t)l * DM + kc * 64) * ADA + j;
        float acc0[8], acc1[8];
#pragma unroll
        for (int b = 0; b < 8; ++b) { acc0[b] = 0.f; acc1[b] = 0.f; }
#pragma unroll 1
        for (int kh = 0; kh < 4; ++kh) {
            f32x2 wv[16];
#pragma unroll
            for (int k = 0; k < 16; ++k) wv[k] = __builtin_nontemporal_load((const f32x2*)(w + (size_t)(kh * 16 + k) * ADA));
#pragma unroll
            for (int k = 0; k < 16; ++k) { const f32x4 s0 = *(const LAS f32x4*)(sc + (kh * 16 + k) * 8), s1 = *(const LAS f32x4*)(sc + (kh * 16 + k) * 8 + 4);
                acc0[0] += s0.x * wv[k].x; acc0[1] += s0.y * wv[k].x; acc0[2] += s0.z * wv[k].x; acc0[3] += s0.w * wv[k].x; acc0[4] += s1.x * wv[k].x; acc0[5] += s1.y * wv[k].x; acc0[6] += s1.z * wv[k].x; acc0[7] += s1.w * wv[k].x;
                acc1[0] += s0.x * wv[k].y; acc1[1] += s0.y * wv[k].y; acc1[2] += s0.z * wv[k].y; acc1[3] += s0.w * wv[k].y; acc1[4] += s1.x * wv[k].y; acc1[5] += s1.y * wv[k].y; acc1[6] += s1.z * wv[k].y; acc1[7] += s1.w * wv[k].y; } }
#pragma unroll
        for (int b = 0; b < 8; ++b) *(f32x2*)(part + ((size_t)(l * 32 + kc) * 8 + b) * ADA + j) = (f32x2){acc0[b], acc1[b]};
    }
    __syncthreads();
}
__device__ __forceinline__ void rope_table(Frame& F, KArgs a) {
    float* cs = (float*)(a->ws + WS_ROPE); float* sn = cs + SEQ * 32;
    if (F.gw == 0) { float* gp = (float*)(a->ws + WS_GP); for (int i = F.lane; i < DEPTH * 192; i += 64) gp[i] = a->g_qn[i] * ((i % 192) < 128 ? a->g_kn[i] : 1.f); }
    for (int idx = F.gw * 64 + F.lane; idx < SEQ * 32; idx += F.NGW * 64) {
        const int pos = idx >> 5, i = idx & 31;
        const float freq = (float)exp(-(double)i * (9.210340371976184 / 32.0));
        const float ang = (float)pos * freq;
        const double ad = (double)ang; const double kq = rint(ad * 0.6366197723675814);
        double r = fma(-kq, 1.5707963267948966, ad); r = fma(-kq, 6.123233995736766e-17, r);
        const double r2 = r * r;
        const double s = r * (1.0 + r2 * (-1.0 / 6 + r2 * (1.0 / 120 + r2 * (-1.0 / 5040 + r2 * (1.0 / 362880 + r2 * (-1.0 / 39916800 + r2 * (1.0 / 6227020800.0)))))));
        const double c = 1.0 + r2 * (-0.5 + r2 * (1.0 / 24 + r2 * (-1.0 / 720 + r2 * (1.0 / 40320 + r2 * (-1.0 / 3628800 + r2 * (1.0 / 479001600 + r2 * (-1.0 / 87178291200.0)))))));
        const int q = (int)((long long)kq & 3);
        const double sv = (q == 0) ? s : (q == 1) ? c : (q == 2) ? -s : -c;
        const double cv = (q == 0) ? c : (q == 1) ? -s : (q == 2) ? -c : s;
        cs[idx] = (float)cv; sn[idx] = (float)sv;
    }
}
__device__ __forceinline__ void adaln_reduce(Frame& F, KArgs a) {
    const float* part = (const float*)(a->ws + WS_Z); float* mod = (float*)(a->ws + WS_MOD);
    for (int idx = F.gw * 64 + F.lane; idx < 2 * 8 * ADA; idx += F.NGW * 64) {
        const int l = idx / (8 * ADA), r = idx % (8 * ADA), b = r / ADA, j = r % ADA;
        float s = a->b_ada[l * ADA + j];
        for (int kc = 0; kc < 32; ++kc) s += part[((size_t)(l * 32 + kc) * 8 + b) * ADA + j];
        mod[idx] = s;
    }
}

template <bool INBF, bool F8OUT = false>
__device__ __forceinline__ void norm_rows(Frame& F, const void* xin, const float* g, const float* mod_l, int shift_idx, int scale_idx, bf16* H, unsigned char* H8 = nullptr) {
    const int R = (((M + F.NGW - 1) / F.NGW) + 3) & ~3;
    const int m0 = F.gw * R, m1 = (m0 + R < M) ? m0 + R : M;
    int bcur = -1;
    float gs[32], sh[32];
    constexpr int RB = INBF ? 4 : 2;
    for (int m = m0; m < m1; m += RB) {
        const int b = m >> 11;
        if (b != bcur) { bcur = b;
            const float* shp = mod_l + (size_t)b * ADA + shift_idx * DM; const float* scp = mod_l + (size_t)b * ADA + scale_idx * DM;
            if (INBF) {
#pragma unroll
                for (int j = 0; j < 4; ++j) { const int col = 8 * F.lane + 512 * j;
#pragma unroll
                    for (int hh = 0; hh < 2; ++hh) { const f32x4 gv = *(const f32x4*)(g + col + 4 * hh), sv = *(const f32x4*)(scp + col + 4 * hh), hv = *(const f32x4*)(shp + col + 4 * hh);
#pragma unroll
                        for (int e = 0; e < 4; ++e) { gs[8 * j + 4 * hh + e] = gv[e] * (1.f + sv[e]); sh[8 * j + 4 * hh + e] = hv[e]; } } }
            } else {
#pragma unroll
                for (int j = 0; j < 8; ++j) { const int col = 4 * F.lane + 256 * j; const f32x4 gv = *(const f32x4*)(g + col), sv = *(const f32x4*)(scp + col), hv = *(const f32x4*)(shp + col);
#pragma unroll
                    for (int e = 0; e < 4; ++e) { gs[4 * j + e] = gv[e] * (1.f + sv[e]); sh[4 * j + e] = hv[e]; } }
            }
        }
        if (INBF) {
            v4u q[RB][4];
#pragma unroll
            for (int r = 0; r < RB; ++r) { const GAS v4u* xr = (const GAS v4u*)((const bf16*)xin + (size_t)(m + r) * DM) + F.lane;
#pragma unroll
                for (int j = 0; j < 4; ++j) q[r][j] = xr[64 * j]; }
#pragma unroll
            for (int r = 0; r < RB; ++r) { float ss = 0.f;
#pragma unroll
                for (int j = 0; j < 4; ++j) ss += (bflo(q[r][j].x) * bflo(q[r][j].x) + bfhi(q[r][j].x) * bfhi(q[r][j].x)) + (bflo(q[r][j].y) * bflo(q[r][j].y) + bfhi(q[r][j].y) * bfhi(q[r][j].y))
                        + (bflo(q[r][j].z) * bflo(q[r][j].z) + bfhi(q[r][j].z) * bfhi(q[r][j].z)) + (bflo(q[r][j].w) * bflo(q[r][j].w) + bfhi(q[r][j].w) * bfhi(q[r][j].w));
                const float rstd = 1.0f / sqrtf(wave_sum(ss) * (1.f / DM) + EPS);
                GAS v4u* o16 = (GAS v4u*)(H + (size_t)(m + r) * DM) + F.lane;
#pragma unroll
                for (int j = 0; j < 4; ++j) { v4u o;
                    o.x = pk2(bflo(q[r][j].x) * rstd * gs[8 * j + 0] + sh[8 * j + 0], bfhi(q[r][j].x) * rstd * gs[8 * j + 1] + sh[8 * j + 1]); o.y = pk2(bflo(q[r][j].y) * rstd * gs[8 * j + 2] + sh[8 * j + 2], bfhi(q[r][j].y) * rstd * gs[8 * j + 3] + sh[8 * j + 3]);
                    o.z = pk2(bflo(q[r][j].z) * rstd * gs[8 * j + 4] + sh[8 * j + 4], bfhi(q[r][j].z) * rstd * gs[8 * j + 5] + sh[8 * j + 5]); o.w = pk2(bflo(q[r][j].w) * rstd * gs[8 * j + 6] + sh[8 * j + 6], bfhi(q[r][j].w) * rstd * gs[8 * j + 7] + sh[8 * j + 7]);
                    o16[64 * j] = o;
                    if (F8OUT) { const float h8s = (float)(1 << H8_LOG2); v2u o8;
                        o8.x = pk4_fp8((bflo(q[r][j].x) * rstd * gs[8 * j + 0] + sh[8 * j + 0]) * h8s, (bfhi(q[r][j].x) * rstd * gs[8 * j + 1] + sh[8 * j + 1]) * h8s, (bflo(q[r][j].y) * rstd * gs[8 * j + 2] + sh[8 * j + 2]) * h8s, (bfhi(q[r][j].y) * rstd * gs[8 * j + 3] + sh[8 * j + 3]) * h8s);
                        o8.y = pk4_fp8((bflo(q[r][j].z) * rstd * gs[8 * j + 4] + sh[8 * j + 4]) * h8s, (bfhi(q[r][j].z) * rstd * gs[8 * j + 5] + sh[8 * j + 5]) * h8s, (bflo(q[r][j].w) * rstd * gs[8 * j + 6] + sh[8 * j + 6]) * h8s, (bfhi(q[r][j].w) * rstd * gs[8 * j + 7] + sh[8 * j + 7]) * h8s);
                        *(GAS v2u*)(H8 + (size_t)(m + r) * DM + 8 * F.lane + 512 * j) = o8; } } }
        } else {
            f32x4 v[RB][8];
#pragma unroll
            for (int r = 0; r < RB; ++r) { const GAS f32x4* xr = (const GAS f32x4*)((const float*)xin + (size_t)(m + r) * DM) + F.lane;
#pragma unroll
                for (int j = 0; j < 8; ++j) v[r][j] = xr[64 * j]; }
#pragma unroll
            for (int r = 0; r < RB; ++r) { float ss = 0.f;
#pragma unroll
                for (int j = 0; j < 8; ++j) ss += (v[r][j].x * v[r][j].x + v[r][j].y * v[r][j].y) + (v[r][j].z * v[r][j].z + v[r][j].w * v[r][j].w);
                const float rstd = 1.0f / sqrtf(wave_sum(ss) * (1.f / DM) + EPS);
                GAS v2u* o8 = (GAS v2u*)(H + (size_t)(m + r) * DM) + F.lane;
#pragma unroll
                for (int j = 0; j < 8; ++j) { v2u o; o.x = pk2(v[r][j].x * rstd * gs[4 * j + 0] + sh[4 * j + 0], v[r][j].y * rstd * gs[4 * j + 1] + sh[4 * j + 1]); o.y = pk2(v[r][j].z * rstd * gs[4 * j + 2] + sh[4 * j + 2], v[r][j].w * rstd * gs[4 * j + 3] + sh[4 * j + 3]);
                    o8[64 * j] = o;
                    if (F8OUT) { const float h8s = (float)(1 << H8_LOG2);
                        *(GAS unsigned*)(H8 + (size_t)(m + r) * DM + 4 * F.lane + 256 * j) = pk4_fp8((v[r][j].x * rstd * gs[4 * j + 0] + sh[4 * j + 0]) * h8s, (v[r][j].y * rstd * gs[4 * j + 1] + sh[4 * j + 1]) * h8s, (v[r][j].z * rstd * gs[4 * j + 2] + sh[4 * j + 2]) * h8s, (v[r][j].w * rstd * gs[4 * j + 3] + sh[4 * j + 3]) * h8s); } } }
        }
    }
}

template <int W_>
__device__ __forceinline__ void pooled_block(const bf16* Z, bf16* BR, int mb, int ch) {
    const int t0 = mb & (SEQ - 1);
    v4u q[W_ + 3];
#pragma unroll
    for (int r = 0; r < W_ + 3; ++r) { const int dt = r - (W_ - 1); const int mm = (t0 + dt >= 0) ? mb + dt : mb; q[r] = *(const v4u*)(Z + (size_t)mm * ZW + ZU + ch * 8); }
    float S[8];
#pragma unroll
    for (int e = 0; e < 8; ++e) S[e] = 0.f;
#pragma unroll
    for (int r = 0; r < W_ + 3; ++r) {
        const float f[8] = {bflo(q[r].x), bfhi(q[r].x), bflo(q[r].y), bfhi(q[r].y), bflo(q[r].z), bfhi(q[r].z), bflo(q[r].w), bfhi(q[r].w)};
        const float wgt = (t0 + r - (W_ - 1) >= 0) ? 1.f : 0.f;
#pragma unroll
        for (int e = 0; e < 8; ++e) S[e] += wgt * f[e];
        if (r >= W_ - 1) { const int i = r - (W_ - 1), t = t0 + i; const int cnt = (t + 1 < W_) ? t + 1 : W_; const float inv = 1.f / (float)cnt;
            v4u o; o.x = pk2(S[0] * inv - f[0], S[1] * inv - f[1]); o.y = pk2(S[2] * inv - f[2], S[3] * inv - f[3]); o.z = pk2(S[4] * inv - f[4], S[5] * inv - f[5]); o.w = pk2(S[6] * inv - f[6], S[7] * inv - f[7]);
            *(v4u*)(BR + (size_t)(mb + i) * BRW + ch * 8) = o;
            const float g0[8] = {bflo(q[i].x), bfhi(q[i].x), bflo(q[i].y), bfhi(q[i].y), bflo(q[i].z), bfhi(q[i].z), bflo(q[i].w), bfhi(q[i].w)};
            const float wo = (t0 + i - (W_ - 1) >= 0) ? 1.f : 0.f;
#pragma unroll
            for (int e = 0; e < 8; ++e) S[e] -= wo * g0[e]; }
    }
}
__device__ __forceinline__ void prep_pooled(Frame& F, KArgs a) {
    const bf16* Z = (const bf16*)(a->ws + WS_Z); bf16* BR = (bf16*)(a->ws + WS_BR);
    for (int p = F.gw; p < M / 8; p += F.NGW) {
        const int mb = (2 * p + (F.lane >> 5)) * 4, c = F.lane & 31;
        pooled_block<2>(Z, BR, mb, c); pooled_block<4>(Z, BR, mb, 32 + c); pooled_block<8>(Z, BR, mb, 64 + c); pooled_block<16>(Z, BR, mb, 96 + c);
    }
}
__device__ __forceinline__ void prep_rstd(Frame& F, KArgs a) {
    const bf16* Z = (const bf16*)(a->ws + WS_Z); float* RS = (float*)(a->ws + WS_RSTD);
    const int R = (((M + F.NGW - 1) / F.NGW) + 3) & ~3;
    const int m0 = F.gw * R, m1 = (m0 + R < M) ? m0 + R : M;
    for (int m = m0; m < m1; m += 4) {
        v4u q[4], k[4];
#pragma unroll
        for (int r = 0; r < 4; ++r) { q[r] = *(const v4u*)(Z + (size_t)(m + r) * ZW + ZQL + F.lane * 8); k[r] = *(const v4u*)(Z + (size_t)(m + r) * ZW + ZKVL + (F.lane & 31) * 8); }
#pragma unroll
        for (int r = 0; r < 4; ++r) {
            float s = bflo(q[r].x) * bflo(q[r].x) + bfhi(q[r].x) * bfhi(q[r].x) + bflo(q[r].y) * bflo(q[r].y) + bfhi(q[r].y) * bfhi(q[r].y) + bflo(q[r].z) * bflo(q[r].z) + bfhi(q[r].z) * bfhi(q[r].z) + bflo(q[r].w) * bflo(q[r].w) + bfhi(q[r].w) * bfhi(q[r].w);
            float s2 = bflo(k[r].x) * bflo(k[r].x) + bfhi(k[r].x) * bfhi(k[r].x) + bflo(k[r].y) * bflo(k[r].y) + bfhi(k[r].y) * bfhi(k[r].y) + bflo(k[r].z) * bflo(k[r].z) + bfhi(k[r].z) * bfhi(k[r].z) + bflo(k[r].w) * bflo(k[r].w) + bfhi(k[r].w) * bfhi(k[r].w);
            if (F.lane >= 32) s2 = 0.f;
            s = wave_sum(s); s2 = wave_sum(s2);
            if (F.lane == 0) { RS[(m + r) * 2] = 1.0f / sqrtf(s * (1.f / 512) + EPS); RS[(m + r) * 2 + 1] = 1.0f / sqrtf(s2 * (1.f / 256) + EPS); } }
    }
}
__device__ __forceinline__ float logsigmoidf_(float x) { return fminf(x, 0.f) - log1pf(expf(-fabsf(x))); }
__device__ __forceinline__ void prep_mlstm(Frame& F, KArgs a, int l) {
    const float* IFB = (const float*)(a->ws + WS_IF); float* AS = (float*)(a->ws + WS_ML); float* MX = AS + 32 * SEQ; float* EX = MX + 32 * SEQ; float* AS2 = EX + 2 * 32 * SEQ; float* MX2 = AS2 + 32 * SEQ;
    LAS float* wsum = (LAS float*)F.lds; LAS float* wmax = wsum + 8;
    for (int bh = blockIdx.x; bh < 32; bh += F.G) {
        const int b = bh >> 2, h = bh & 3, t0 = 4 * F.tid;
        const float bi = a->b_mgate[l * 8 + h], bfv = a->b_mgate[l * 8 + 4 + h];
        float lf[4], ig[4];
#pragma unroll
        for (int j = 0; j < 4; ++j) { const size_t mm = (size_t)(b * SEQ + t0 + j); lf[j] = logsigmoidf_(IFB[mm * 8 + 4 + h] + bfv); ig[j] = IFB[mm * 8 + h] + bi; }
        const float c0 = lf[0], c1 = c0 + lf[1], c2 = c1 + lf[2], c3 = c2 + lf[3];
        float inc = c3;
#pragma unroll
        for (int o = 1; o < 64; o <<= 1) { const float v = lane_get(inc, F.lane - o); if (F.lane >= o) inc += v; }
        __syncthreads();
        if (F.lane == 63) wsum[F.wave] = inc;
        __syncthreads();
        float woff = 0.f;
        for (int w = 0; w < F.wave; ++w) woff += wsum[w];
        const float ex = woff + inc - c3;
        const float Fv[4] = {ex + c0, ex + c1, ex + c2, ex + c3};
        float av[4], mv[4];
#pragma unroll
        for (int j = 0; j < 4; ++j) av[j] = ig[j] - Fv[j];
        mv[0] = av[0]; mv[1] = fmaxf(mv[0], av[1]); mv[2] = fmaxf(mv[1], av[2]); mv[3] = fmaxf(mv[2], av[3]);
        float imax = mv[3];
#pragma unroll
        for (int o = 1; o < 64; o <<= 1) { const float v = lane_get(imax, F.lane - o); if (F.lane >= o) imax = fmaxf(imax, v); }
        if (F.lane == 63) wmax[F.wave] = imax;
        __syncthreads();
        float emax = -INFINITY;
        for (int w = 0; w < F.wave; ++w) emax = fmaxf(emax, wmax[w]);
        { const float up = lane_get(imax, F.lane - 1); if (F.lane > 0) emax = fmaxf(emax, up); }
        float A2c = mv[3] * LOG2E;
        A2c = row16_max(A2c); A2c = fmaxf(A2c, lane_get(A2c, F.lane ^ 16));
        const float B2c = lane_get(emax, F.lane & 32) * LOG2E;
        const float B2n = fmaxf(B2c, A2c);
        float* MLb = (float*)(a->ws + WS_ML);
        if ((F.lane & 31) == 0) { const int c = F.tid >> 5; MLb[ML_FA + bh * 16 + c] = __builtin_amdgcn_exp2f(B2c - B2n); MLb[ML_FB + bh * 16 + c] = __builtin_amdgcn_exp2f(A2c - B2n); }
#pragma unroll
        for (int j = 0; j < 4; ++j) { const float Mv = fmaxf(emax, mv[j]); const int o = bh * SEQ + t0 + j;
            AS[o] = av[j]; MX[o] = Mv; EX[o] = expf(-Fv[j] - Mv); AS2[o] = av[j] * LOG2E; MX2[o] = Mv * LOG2E;
            MLb[ML_ECH + o] = 0.08838834764831845f * __builtin_amdgcn_exp2f(av[j] * LOG2E - A2c);
            MLb[ML_FQ + o] = __builtin_amdgcn_exp2f(B2c - Mv * LOG2E); }
    }
    __syncthreads();
}

__device__ __forceinline__ void kstats(Frame& F, KArgs a, int l) {
    const bf16* Z = (const bf16*)(a->ws + WS_Z); const bf16* KV = (const bf16*)(a->ws + WS_KVRAW); bf16* KR = (bf16*)(a->ws + WS_KR); float* RK = (float*)(a->ws + WS_RK);
    const float* cs = (const float*)(a->ws + WS_ROPE); const float* sn = cs + SEQ * 32;
    const int fi = F.lane & 31;
    const float gk = a->g_kn[l * 192 + 128 + F.lane];
    const int R = (((M + F.NGW - 1) / F.NGW) + 3) & ~3;
    const int m0 = F.gw * R, m1 = (m0 + R < M) ? m0 + R : M;
    for (int mq = m0; mq < m1; mq += 4) {
        v4u q0[4], q1[4]; float kr[4], c[4], sv[4];
#pragma unroll
        for (int r = 0; r < 4; ++r) { const int m = mq + r, pos = m & (SEQ - 1);
            q0[r] = *(const v4u*)(KV + (size_t)m * KVW + (F.lane >> 4) * 256 + (F.lane & 15) * 8); q1[r] = *(const v4u*)(KV + (size_t)m * KVW + (4 + (F.lane >> 4)) * 256 + (F.lane & 15) * 8);
            kr[r] = bf2f(Z[(size_t)m * ZW + ZKR + F.lane]); c[r] = cs[pos * 32 + fi]; sv[r] = sn[pos * 32 + fi]; }
#pragma unroll
        for (int r = 0; r < 4; ++r) { const int m = mq + r, pos = m & (SEQ - 1), b = m >> 11;
            const float sgn_s = (F.lane < 32) ? -sv[r] : sv[r];
            float s0 = (bflo(q0[r].x) * bflo(q0[r].x) + bfhi(q0[r].x) * bfhi(q0[r].x)) + (bflo(q0[r].y) * bflo(q0[r].y) + bfhi(q0[r].y) * bfhi(q0[r].y)) + (bflo(q0[r].z) * bflo(q0[r].z) + bfhi(q0[r].z) * bfhi(q0[r].z)) + (bflo(q0[r].w) * bflo(q0[r].w) + bfhi(q0[r].w) * bfhi(q0[r].w));
            float s1 = (bflo(q1[r].x) * bflo(q1[r].x) + bfhi(q1[r].x) * bfhi(q1[r].x)) + (bflo(q1[r].y) * bflo(q1[r].y) + bfhi(q1[r].y) * bfhi(q1[r].y)) + (bflo(q1[r].z) * bflo(q1[r].z) + bfhi(q1[r].z) * bfhi(q1[r].z)) + (bflo(q1[r].w) * bflo(q1[r].w) + bfhi(q1[r].w) * bfhi(q1[r].w));
            s0 = row16_sum(s0); s1 = row16_sum(s1);
            const float sr = wave_sum(kr[r] * kr[r]);
            const float y = kr[r] * gk, other = swap32(y, F.lane);
            KR[(size_t)m * 64 + F.lane] = (bf16)f2bf(y * c[r] + other * sgn_s);
            if ((F.lane & 15) == 0) { const int h = F.lane >> 4;
                RK[(size_t)(b * 8 + h) * SEQ + pos] = 1.0f / sqrtf((s0 + sr) * (1.f / 192) + EPS); RK[(size_t)(b * 8 + 4 + h) * SEQ + pos] = 1.0f / sqrtf((s1 + sr) * (1.f / 192) + EPS); } }
    }
}

namespace fa {
typedef short bf16x8 __attribute__((ext_vector_type(8)));
typedef short s16x4 __attribute__((ext_vector_type(4)));
typedef float f32x16 __attribute__((ext_vector_type(16)));
typedef unsigned u32x4 __attribute__((ext_vector_type(4)));
__device__ __forceinline__ int v_st(int k, int c) { const int kk = (k & ~0xC) | ((k & 4) << 1) | ((k & 8) >> 1); return ((kk >> 3) * 4 + (c >> 5)) * 512 + ((kk & 7) * 32 + (c & 31)) * 2; }
__device__ __forceinline__ int v_rd_base(int lane) { return ((lane & 3) << 3) | (((lane >> 2) & 3) << 6) | (((lane >> 4) & 1) << 5) | (((lane >> 5) & 1) << 8); }
constexpr int v_rd_off(int d0, int ks, int half) { return d0 * 512 + ks * 4096 + half * 2048; }
__device__ __forceinline__ int crow(int r, int hi) { return (r & 3) + 8 * (r >> 2) + 4 * hi; }
__device__ __forceinline__ unsigned cvtpk(float lo, float hi) { unsigned r; asm volatile("v_cvt_pk_bf16_f32 %0, %1, %2" : "=v"(r) : "v"(lo), "v"(hi)); return r; }
#define FA_BAR() do { asm volatile("s_waitcnt lgkmcnt(0)" ::: "memory"); __builtin_amdgcn_s_barrier(); asm volatile("" ::: "memory"); } while (0)
#define FA_PK4(P, B_, OUT) do { unsigned a0 = cvtpk(P[B_+0], P[B_+1]), a1 = cvtpk(P[B_+2], P[B_+3]); unsigned b0 = cvtpk(P[B_+4], P[B_+5]), b1 = cvtpk(P[B_+6], P[B_+7]); \
        auto r0 = __builtin_amdgcn_permlane32_swap(a0, b0, false, false); auto r1 = __builtin_amdgcn_permlane32_swap(a1, b1, false, false); \
        u32x4 w = {r0[0], r1[0], r0[1], r1[1]}; OUT = __builtin_bit_cast(bf16x8, w); } while (0)
__device__ __forceinline__ float swap_max(float v) { auto rr = __builtin_amdgcn_permlane32_swap(__float_as_uint(v), __float_as_uint(v), false, false); return fmaxf(__uint_as_float(rr[0]), __uint_as_float(rr[1])); }
__device__ __forceinline__ float swap_add(float v) { auto rr = __builtin_amdgcn_permlane32_swap(__float_as_uint(v), __float_as_uint(v), false, false); return __uint_as_float(rr[0]) + __uint_as_float(rr[1]); }

template <int MODE>
__device__ __forceinline__ void unit(const Frame& F, KArgs a, int l, int bh, int qb) {
    constexpr int DQK = MODE == 0 ? 192 : 128, DVT = MODE == 0 ? 128 : 256, QBR = MODE == 0 ? 256 : 128, NH = MODE == 0 ? 8 : 4;
    constexpr int PK = DQK * 2, KBYTES = 64 * PK, VBYTES = 64 * DVT * 2, KC8 = DQK / 8, VC8 = DVT / 8, NKC = 64 * KC8 / 512, NVC = 64 * VC8 / 512, NQ = DQK / 16;
    int lane_ = F.lane; asm volatile("" : "+v"(lane_));
    const int wid = F.wave, lane = lane_, r32 = lane & 31, hi = lane >> 5;
    const int b = bh / NH, h = bh % NH;
    const int rb = MODE == 0 ? wid : (wid >> 1), vh = MODE == 0 ? 0 : (wid & 1);
    constexpr bool CHK = (MODE == 1) && (ML_CHUNKED != 0);
    const int P0 = qb * QBR, qlo = P0 + rb * 32, qpos = qlo + r32, T0 = CHK ? P0 / 64 : 0, NT = (P0 + QBR) / 64 - T0;
    unsigned char* ws = a->ws;
    const bf16 *Qg, *Kg, *Vg; int qp, kp, vp;
    if (MODE == 0) { Qg = (const bf16*)(ws + WS_QRAW) + (size_t)(b * SEQ) * QW + h * 192; qp = QW; Kg = (const bf16*)(ws + WS_KVRAW) + (size_t)(b * SEQ) * KVW + h * 256; kp = KVW;
                     Vg = (const bf16*)(ws + WS_KVRAW) + (size_t)(b * SEQ) * KVW + h * 256 + 128; vp = KVW; }
    else { const bf16* Zb = (const bf16*)(ws + WS_Z) + (size_t)(b * SEQ) * ZW; Qg = Zb + ZQ + h * 128; Kg = Zb + ZK + h * 128; Vg = Zb + ZV + h * 256; qp = kp = vp = ZW; }
    constexpr int NST = 3;
    LAS unsigned char* K_lds = F.lds; LAS unsigned char* V_lds = F.lds + NST * KBYTES;
    LAS unsigned char* A_lds = F.lds + NST * (KBYTES + VBYTES);
    LAS float* scr = (LAS float*)(F.lds + NST * (KBYTES + VBYTES) + NST * 2048) + wid * 64; LAS float* al_l = scr; LAS float* li_l = scr + 32;
    LAS float* xs = (LAS float*)(F.lds + NST * (KBYTES + VBYTES) + NST * 2048 + 2048);
    static_assert(NST * (KBYTES + VBYTES) + NST * 2048 + 2048 + 1024 <= RING_BYTES, "flash LDS map");
    bf16x8 qr[NQ];
    { const unsigned qoff = (unsigned)(qpos * qp + hi * 8) * 2u;
#pragma unroll
      for (int d0 = 0; d0 < NQ; ++d0) qr[d0] = *(const bf16x8*)((const char*)Qg + qoff + d0 * 32); }
    unsigned kgo[NKC], vgo[NVC];
#pragma unroll
    for (int i = 0; i < NKC; ++i) { const int X = (wid + 8 * i) * 1024 + lane * 16;
        if (X < 16384) { const int row = X >> 8, j = (X >> 4) & 15; kgo[i] = (unsigned)(row * kp) * 2u + (unsigned)((j ^ (row & 15)) << 4); }
        else { const int Y = X - 16384, row = Y >> 7, j = (Y >> 4) & 7; kgo[i] = (unsigned)(row * 128) + (unsigned)((j ^ ((row >> 1) & 7)) << 4); } }
#pragma unroll
    for (int i = 0; i < NVC; ++i) { const int X = (wid + 8 * i) * 1024 + lane * 16, img = X >> 14, Xi = X & 16383, sub = Xi >> 9, within = Xi & 511;
        const int kk = (sub >> 2) * 8 + (within >> 6), k = (kk & ~0xC) | ((kk & 4) << 1) | ((kk & 8) >> 1), col = img * 128 + (sub & 3) * 32 + ((within & 63) >> 1);
        vgo[i] = (unsigned)(k * vp + col) * 2u; }
#define FA_DMA16(ldsaddr, voff, sbase) asm volatile("s_nop 4\n\ts_mov_b32 m0, %0\n\ts_nop 0\n\tglobal_load_lds_dwordx4 %1, %2" :: "s"(ldsaddr), "v"(voff), "s"(sbase) : "memory", "m0")
#define FA_DMA4(ldsaddr, voff, sbase) asm volatile("s_nop 4\n\ts_mov_b32 m0, %0\n\ts_nop 0\n\tglobal_load_lds_dword %1, %2" :: "s"(ldsaddr), "v"(voff), "s"(sbase) : "memory", "m0")
    const unsigned k_m0 = (unsigned)__builtin_amdgcn_readfirstlane((int)((unsigned)(uintptr_t)K_lds + wid * 1024)), v_m0 = (unsigned)__builtin_amdgcn_readfirstlane((int)((unsigned)(uintptr_t)V_lds + wid * 1024)),
                   a_m0 = (unsigned)__builtin_amdgcn_readfirstlane((int)((unsigned)(uintptr_t)A_lds + wid * 256));
    const unsigned lane4 = (unsigned)lane * 4u;
#define FA_ISSUE(t, buf) do { const char* kb_ = (const char*)(Kg + (size_t)((T0 + (t)) * 64) * kp); const char* vb_ = (const char*)(Vg + (size_t)((T0 + (t)) * 64) * vp); const char* kr_ = (const char*)(KRg + (size_t)((T0 + (t)) * 64) * 64); \
        _Pragma("unroll") for (int i = 0; i < NKC; ++i) FA_DMA16(k_m0 + (unsigned)((buf) * KBYTES + 8192 * i), kgo[i], (i < 2 ? kb_ : kr_)); \
        _Pragma("unroll") for (int i = 0; i < NVC; ++i) FA_DMA16(v_m0 + (unsigned)((buf) * VBYTES + 8192 * i), vgo[i], vb_); \
        FA_DMA4(a_m0 + (unsigned)((buf) * 2048), lane4, (const char*)(AS2 + (T0 + (t)) * 64)); } while (0)
    constexpr int NDMA = NKC + NVC + 1;
    f32x16 o[4];
#pragma unroll
    for (int d = 0; d < 4; ++d)
#pragma unroll
        for (int r = 0; r < 16; ++r) o[d][r] = 0.f;
    float m_reg = -1e30f, l_reg = 0.f;
    const float* AS2 = MODE == 1 ? (const float*)(ws + WS_ML) + 4 * 32 * SEQ + bh * SEQ : (const float*)(ws + WS_RK) + (size_t)bh * SEQ;
    const bf16* KRg = (const bf16*)(ws + WS_KR) + (size_t)(b * SEQ) * 64;
    const float Mq = MODE == 1 ? ((const float*)(ws + WS_ML) + 5 * 32 * SEQ)[bh * SEQ + qpos] : 0.f;
    const int hs16 = hi ^ (r32 & 15), hs8 = hi ^ ((r32 >> 1) & 7);
    const unsigned vbase = (unsigned)(uintptr_t)V_lds + vh * 16384 + v_rd_base(lane);
    FA_ISSUE(0, 0);
    if (NT > 1) FA_ISSUE(1, 1);
    if (MODE == 0) {
        const float* gp = (const float*)(ws + WS_GP) + l * 192 + hi * 8;
        const float* csr = (const float*)(ws + WS_ROPE) + (size_t)qpos * 32 + hi * 8; const float* snr = csr + SEQ * 32;
        f32x4 G[8][2];
#pragma unroll
        for (int d0 = 0; d0 < 8; ++d0) { G[d0][0] = *(const f32x4*)(gp + d0 * 16); G[d0][1] = *(const f32x4*)(gp + d0 * 16 + 4); }
        const float qscale = 0.07216878364870322f * LOG2E;
        float ss = 0.f;
#pragma unroll
        for (int d0 = 0; d0 < NQ; ++d0) { const u32x4 w = __builtin_bit_cast(u32x4, qr[d0]);
            ss += (bflo(w.x) * bflo(w.x) + bfhi(w.x) * bfhi(w.x)) + (bflo(w.y) * bflo(w.y) + bfhi(w.y) * bfhi(w.y)) + (bflo(w.z) * bflo(w.z) + bfhi(w.z) * bfhi(w.z)) + (bflo(w.w) * bflo(w.w) + bfhi(w.w) * bfhi(w.w)); }
        const float rq = qscale / sqrtf(swap_add(ss) * (1.f / 192) + EPS);
#pragma unroll
        for (int d0 = 0; d0 < 8; ++d0) { const u32x4 w = __builtin_bit_cast(u32x4, qr[d0]); const f32x4 g0 = G[d0][0], g1 = G[d0][1];
            u32x4 o; o.x = cvtpk(bflo(w.x) * rq * g0.x, bfhi(w.x) * rq * g0.y); o.y = cvtpk(bflo(w.y) * rq * g0.z, bfhi(w.y) * rq * g0.w);
            o.z = cvtpk(bflo(w.z) * rq * g1.x, bfhi(w.z) * rq * g1.y); o.w = cvtpk(bflo(w.w) * rq * g1.z, bfhi(w.w) * rq * g1.w);
            qr[d0] = __builtin_bit_cast(bf16x8, o); }
        __builtin_amdgcn_sched_barrier(0);
        f32x4 GR[4][2], CS[2][2], SN[2][2];
#pragma unroll
        for (int d0 = 0; d0 < 4; ++d0) { GR[d0][0] = *(const f32x4*)(gp + (8 + d0) * 16); GR[d0][1] = *(const f32x4*)(gp + (8 + d0) * 16 + 4); }
#pragma unroll
        for (int q2 = 0; q2 < 2; ++q2) { CS[q2][0] = *(const f32x4*)(csr + q2 * 16); CS[q2][1] = *(const f32x4*)(csr + q2 * 16 + 4); SN[q2][0] = *(const f32x4*)(snr + q2 * 16); SN[q2][1] = *(const f32x4*)(snr + q2 * 16 + 4); }
#pragma unroll
        for (int d0 = 8; d0 < 10; ++d0) { const u32x4 w1 = __builtin_bit_cast(u32x4, qr[d0]), w2 = __builtin_bit_cast(u32x4, qr[d0 + 2]);
            const float x1[8] = {bflo(w1.x), bfhi(w1.x), bflo(w1.y), bfhi(w1.y), bflo(w1.z), bfhi(w1.z), bflo(w1.w), bfhi(w1.w)}, x2[8] = {bflo(w2.x), bfhi(w2.x), bflo(w2.y), bfhi(w2.y), bflo(w2.z), bfhi(w2.z), bflo(w2.w), bfhi(w2.w)};
            float y1[8], y2[8];
#pragma unroll
            for (int e = 0; e < 8; ++e) { const float a1 = x1[e] * rq * GR[d0 - 8][e >> 2][e & 3], a2 = x2[e] * rq * GR[d0 - 6][e >> 2][e & 3], c_ = CS[d0 - 8][e >> 2][e & 3], s_ = SN[d0 - 8][e >> 2][e & 3];
                y1[e] = a1 * c_ - a2 * s_; y2[e] = a2 * c_ + a1 * s_; }
            u32x4 o1, o2; o1.x = cvtpk(y1[0], y1[1]); o1.y = cvtpk(y1[2], y1[3]); o1.z = cvtpk(y1[4], y1[5]); o1.w = cvtpk(y1[6], y1[7]); o2.x = cvtpk(y2[0], y2[1]); o2.y = cvtpk(y2[2], y2[3]); o2.z = cvtpk(y2[4], y2[5]); o2.w = cvtpk(y2[6], y2[7]);
            qr[d0] = __builtin_bit_cast(bf16x8, o1); qr[d0 + 2] = __builtin_bit_cast(bf16x8, o2); }
    }
    if (CHK && qb > 0) {
        const bf16* Sg = (const bf16*)(ws + WS_DCS) + ((size_t)(bh * 15 + qb - 1) * 256 + vh * 128) * 128;
        const float* ng = (const float*)(ws + WS_ML) + ML_DN + (bh * 15 + qb - 1) * 128;
#pragma unroll
        for (int vp = 0; vp < 2; ++vp) { bf16x8 sf[2][8];
#pragma unroll
            for (int q2 = 0; q2 < 2; ++q2)
#pragma unroll
                for (int ks = 0; ks < 8; ++ks) sf[q2][ks] = *(const bf16x8*)(Sg + (size_t)((2 * vp + q2) * 32 + r32) * 128 + ks * 16 + hi * 8);
#pragma unroll
            for (int ks = 0; ks < 8; ++ks) { o[2 * vp] = __builtin_amdgcn_mfma_f32_32x32x16_bf16(qr[ks], sf[0][ks], o[2 * vp], 0, 0, 0); o[2 * vp + 1] = __builtin_amdgcn_mfma_f32_32x32x16_bf16(qr[ks], sf[1][ks], o[2 * vp + 1], 0, 0, 0); } }
        float dotp = 0.f;
#pragma unroll
        for (int ks = 0; ks < 8; ++ks) { const f32x4 n0 = *(const f32x4*)(ng + ks * 16 + hi * 8), n1 = *(const f32x4*)(ng + ks * 16 + hi * 8 + 4); const u32x4 qw = __builtin_bit_cast(u32x4, qr[ks]);
            dotp += (bflo(qw.x) * n0.x + bfhi(qw.x) * n0.y) + (bflo(qw.y) * n0.z + bfhi(qw.y) * n0.w) + (bflo(qw.z) * n1.x + bfhi(qw.z) * n1.y) + (bflo(qw.w) * n1.z + bfhi(qw.w) * n1.w); }
        const float fq = ((const float*)(ws + WS_ML) + ML_FQ)[bh * SEQ + qpos];
        l_reg = fq * dotp;
        if (hi == 0) al_l[r32] = fq; LDS_WAIT();
#pragma unroll
        for (int r = 0; r < 16; ++r) { const float al = al_l[crow(r, hi)];
#pragma unroll
            for (int d = 0; d < 4; ++d) o[d][r] *= al; }
    }
    if (NT > 1) asm volatile("s_waitcnt vmcnt(%0)" :: "i"(NDMA) : "memory"); else VM_WAIT();
    FA_BAR();
    int buf = 0;
    for (int t = 0; t < NT; ++t) {
        const int kb = (T0 + t) * 64;
        if (t + 2 < NT) { const int nb = buf == 0 ? 2 : buf - 1; FA_ISSUE(t + 2, nb); }
        const bool act = kb <= qlo + 31;
        if (act) {
            f32x16 p0, p1;
#pragma unroll
            for (int r = 0; r < 16; ++r) { p0[r] = 0.f; p1[r] = 0.f; }
            const LAS unsigned char* kt = K_lds + buf * KBYTES;
            float w0[16], w1[16];
            if (MODE == 1) {
                const LAS float* a2 = (const LAS float*)(A_lds + (buf * 8 + wid) * 256);
                const int dq = qpos - kb - 4 * hi;
                f32x4 av0[4], av1[4];
#pragma unroll
                for (int g = 0; g < 4; ++g) { av0[g] = *(const LAS f32x4*)(a2 + 8 * g + 4 * hi); av1[g] = *(const LAS f32x4*)(a2 + 32 + 8 * g + 4 * hi); }
                bf16x8 kc0, kc1, kn0, kn1;
                { const LAS unsigned char* ka = kt + r32 * 256 + ((0 ^ hs16) << 4); kc0 = *(const LAS bf16x8*)ka; kc1 = *(const LAS bf16x8*)(ka + 32 * 256); }
#pragma unroll
                for (int d0 = 0; d0 < 8; ++d0) {
                    if (d0 + 1 < 8) { const LAS unsigned char* ka = kt + r32 * 256 + (((2 * (d0 + 1)) ^ hs16) << 4); kn0 = *(const LAS bf16x8*)ka; kn1 = *(const LAS bf16x8*)(ka + 32 * 256); }
                    __builtin_amdgcn_sched_barrier(0);
                    p0 = __builtin_amdgcn_mfma_f32_32x32x16_bf16(kc0, qr[d0], p0, 0, 0, 0);
                    __builtin_amdgcn_sched_barrier(0);
                    { const int r = 2 * d0, g = r >> 2, j = r & 3;
                      const float e0 = 0.08838834764831845f * __builtin_amdgcn_exp2f(av0[g][j] - Mq), e1 = 0.08838834764831845f * __builtin_amdgcn_exp2f(av1[g][j] - Mq);
                      w0[r] = (8 * g + j > dq) ? 0.f : e0; w1[r] = (8 * g + j + 32 > dq) ? 0.f : e1; }
                    __builtin_amdgcn_sched_barrier(0);
                    p1 = __builtin_amdgcn_mfma_f32_32x32x16_bf16(kc1, qr[d0], p1, 0, 0, 0);
                    __builtin_amdgcn_sched_barrier(0);
                    { const int r = 2 * d0 + 1, g = r >> 2, j = r & 3;
                      const float e0 = 0.08838834764831845f * __builtin_amdgcn_exp2f(av0[g][j] - Mq), e1 = 0.08838834764831845f * __builtin_amdgcn_exp2f(av1[g][j] - Mq);
                      w0[r] = (8 * g + j > dq) ? 0.f : e0; w1[r] = (8 * g + j + 32 > dq) ? 0.f : e1; }
                    __builtin_amdgcn_sched_barrier(0);
                    kc0 = kn0; kc1 = kn1;
                }
            } else {
#define FA_KLD(d0_) do { const LAS unsigned char* ka = ((d0_) < 8) ? kt + r32 * 256 + (((2 * (d0_)) ^ hs16) << 4) : kt + 16384 + r32 * 128 + (((2 * ((d0_) - 8)) ^ hs8) << 4); \
                kf[(d0_) & 3][0] = *(const LAS bf16x8*)ka; kf[(d0_) & 3][1] = *(const LAS bf16x8*)(ka + (((d0_) < 8) ? 32 * 256 : 32 * 128)); } while (0)
            { const LAS float* a2 = (const LAS float*)(A_lds + (buf * 8 + wid) * 256);
              f32x4 k0s[4], k1s[4];
#pragma unroll
              for (int g = 0; g < 4; ++g) { k0s[g] = *(const LAS f32x4*)(a2 + 8 * g + 4 * hi); k1s[g] = *(const LAS f32x4*)(a2 + 32 + 8 * g + 4 * hi); }
              bf16x8 kf[4][2];
              FA_KLD(0); FA_KLD(1); FA_KLD(2);
              __builtin_amdgcn_sched_barrier(0);
#pragma unroll
              for (int d0 = 0; d0 < NQ; ++d0) {
                  if (d0 + 3 < NQ) FA_KLD(d0 + 3);
                  __builtin_amdgcn_sched_barrier(0);
                  p0 = __builtin_amdgcn_mfma_f32_32x32x16_bf16(kf[d0 & 3][0], qr[d0], p0, 0, 0, 0);
                  p1 = __builtin_amdgcn_mfma_f32_32x32x16_bf16(kf[d0 & 3][1], qr[d0], p1, 0, 0, 0);
                  __builtin_amdgcn_sched_barrier(0); }
#pragma unroll
              for (int g = 0; g < 4; ++g)
#pragma unroll
                  for (int j = 0; j < 4; ++j) { p0[4 * g + j] *= k0s[g][j]; p1[4 * g + j] *= k1s[g][j]; } }
#undef FA_KLD
            }
            const bool need_mask = kb + 63 > qlo;
            bf16x8 pa0, pa1, pa2, pa3;
            if (MODE == 0) {
                if (need_mask) {
#pragma unroll
                    for (int r = 0; r < 16; ++r) { const int key = kb + crow(r, hi); if (key > qpos) p0[r] = -INFINITY; if (key + 32 > qpos) p1[r] = -INFINITY; } }
                float pmax = p0[0];
#pragma unroll
                for (int r = 1; r < 16; ++r) pmax = fmaxf(pmax, p0[r]);
#pragma unroll
                for (int r = 0; r < 16; ++r) pmax = fmaxf(pmax, p1[r]);
                pmax = swap_max(pmax);
                float mn = m_reg, alpha = 1.f;
                if (!__all(pmax - m_reg <= 8.f)) { mn = fmaxf(m_reg, pmax); alpha = __builtin_amdgcn_exp2f(m_reg - mn); m_reg = mn; }
                float ps = 0.f;
#pragma unroll
                for (int r = 0; r < 16; ++r) { p0[r] = __builtin_amdgcn_exp2f(p0[r] - mn); p1[r] = __builtin_amdgcn_exp2f(p1[r] - mn); ps += p0[r] + p1[r]; }
                ps = swap_add(ps);
                l_reg = l_reg * alpha + ps;
                FA_PK4(p0, 0, pa0); FA_PK4(p0, 8, pa1); FA_PK4(p1, 0, pa2); FA_PK4(p1, 8, pa3);
                if (__any(alpha < 1.f)) { if (hi == 0) al_l[r32] = alpha; LDS_WAIT();
#pragma unroll
                    for (int r = 0; r < 16; ++r) { const float al = al_l[crow(r, hi)];
#pragma unroll
                        for (int d = 0; d < 4; ++d) o[d][r] *= al; } }
            } else {
                float ps = 0.f;
#pragma unroll
                for (int r = 0; r < 16; ++r) { p0[r] *= w0[r]; p1[r] *= w1[r]; ps += p0[r] + p1[r]; }
                l_reg += ps;
                FA_PK4(p0, 0, pa0); FA_PK4(p0, 8, pa1); FA_PK4(p1, 0, pa2); FA_PK4(p1, 8, pa3);
            }
            const unsigned vb = vbase + buf * VBYTES;
#define FA_TRRD(dst, off) asm volatile("ds_read_b64_tr_b16 %0, %1 offset:%2" : "=&v"(dst) : "v"(vb), "i"(off) : "memory")
#define FA_RDKS(set, ks) do { FA_TRRD(set[0], v_rd_off(0, ks, 0)); FA_TRRD(set[1], v_rd_off(0, ks, 1)); FA_TRRD(set[2], v_rd_off(1, ks, 0)); FA_TRRD(set[3], v_rd_off(1, ks, 1)); \
            FA_TRRD(set[4], v_rd_off(2, ks, 0)); FA_TRRD(set[5], v_rd_off(2, ks, 1)); FA_TRRD(set[6], v_rd_off(3, ks, 0)); FA_TRRD(set[7], v_rd_off(3, ks, 1)); } while (0)
#define FA_MMKS(set, pa) do { _Pragma("unroll") for (int d0 = 0; d0 < 4; ++d0) \
            o[d0] = __builtin_amdgcn_mfma_f32_32x32x16_bf16(pa, (bf16x8){set[2 * d0][0], set[2 * d0][1], set[2 * d0][2], set[2 * d0][3], set[2 * d0 + 1][0], set[2 * d0 + 1][1], set[2 * d0 + 1][2], set[2 * d0 + 1][3]}, o[d0], 0, 0, 0); } while (0)
            { s16x4 va[8], vb2[8];
              FA_RDKS(va, 0); FA_RDKS(vb2, 1);
              asm volatile("s_waitcnt lgkmcnt(8)" ::: "memory"); __builtin_amdgcn_sched_barrier(0);
              FA_MMKS(va, pa0); __builtin_amdgcn_sched_barrier(0);
              FA_RDKS(va, 2);
              asm volatile("s_waitcnt lgkmcnt(8)" ::: "memory"); __builtin_amdgcn_sched_barrier(0);
              FA_MMKS(vb2, pa1); __builtin_amdgcn_sched_barrier(0);
              FA_RDKS(vb2, 3);
              asm volatile("s_waitcnt lgkmcnt(8)" ::: "memory"); __builtin_amdgcn_sched_barrier(0);
              FA_MMKS(va, pa2); __builtin_amdgcn_sched_barrier(0);
              asm volatile("s_waitcnt lgkmcnt(0)" ::: "memory"); __builtin_amdgcn_sched_barrier(0);
              FA_MMKS(vb2, pa3); }
#undef FA_MMKS
#undef FA_RDKS
#undef FA_TRRD
        }
        if (t + 2 < NT) asm volatile("s_waitcnt vmcnt(%0)" :: "i"(NDMA) : "memory"); else VM_WAIT();
        FA_BAR();
        buf = buf == 2 ? 0 : buf + 1;
    }
    bf16* BR = (bf16*)(ws + WS_BR);
    const int erow = lane >> 4, ech = lane & 15;
    if (MODE == 0) {
        constexpr int RP = 272;
        LAS unsigned char* sg = F.lds + wid * (32 * RP);
        if (hi == 0) li_l[r32] = l_reg; LDS_WAIT();
#pragma unroll
        for (int r = 0; r < 16; ++r) { const int orow = crow(r, hi); const float rl = __builtin_amdgcn_rcpf(li_l[orow]);
#pragma unroll
            for (int d0 = 0; d0 < 4; ++d0) *(LAS bf16*)(sg + orow * RP + (d0 * 32 + r32) * 2) = (bf16)f2bf(o[d0][r] * rl); }
        LDS_WAIT(); asm volatile("" ::: "memory");
        bf16* Ow = BR + (size_t)(b * SEQ + qlo) * BRW + 1024 + h * 128 + ech * 8;
#pragma unroll
        for (int i = 0; i < 8; ++i) { const int row = 4 * i + erow; const v4u v = *(const LAS v4u*)(sg + row * RP + ech * 16); *(v4u*)(Ow + (size_t)row * BRW) = v; }
    } else {
        constexpr int RP = 528;
        LAS unsigned char* sg = F.lds + wid * (32 * RP);
        static_assert(MODE == 0 || 8 * 32 * RP <= NST * (KBYTES + VBYTES), "mLSTM epilogue images fit the ring");
        const int colb = h * 256 + vh * 128 + ech * 8;
        const bf16* Og = (const bf16*)(ws + WS_Z) + (size_t)(b * SEQ + qlo) * ZW + ZO + colb;
        v4u ogv[8];
#pragma unroll
        for (int i = 0; i < 8; ++i) ogv[i] = *(const v4u*)(Og + (size_t)(4 * i + erow) * ZW);
        const f32x4 g0 = *(const f32x4*)(a->g_mnorm + l * 1024 + colb), g1 = *(const f32x4*)(a->g_mnorm + l * 1024 + colb + 4);
        const float den = swap_add(l_reg);
        const float ex = ((const float*)(ws + WS_ML) + 2 * 32 * SEQ)[bh * SEQ + qpos];
        const float inv = 1.f / fmaxf(fabsf(den), ex);
        if (hi == 0) li_l[r32] = inv; LDS_WAIT();
#pragma unroll
        for (int r = 0; r < 16; ++r) { const int orow = crow(r, hi); const float sc = li_l[orow];
#pragma unroll
            for (int d0 = 0; d0 < 4; ++d0) *(LAS float*)(sg + orow * RP + (d0 * 32 + r32) * 4) = o[d0][r] * sc; }
        LDS_WAIT(); asm volatile("" ::: "memory");
#pragma unroll
        for (int i = 0; i < 8; ++i) { const int row = 4 * i + erow; const f32x4 x0 = *(const LAS f32x4*)(sg + row * RP + ech * 32), x1 = *(const LAS f32x4*)(sg + row * RP + ech * 32 + 16);
            float ss = (x0.x * x0.x + x0.y * x0.y) + (x0.z * x0.z + x0.w * x0.w) + (x1.x * x1.x + x1.y * x1.y) + (x1.z * x1.z + x1.w * x1.w);
            ss = row16_sum(ss);
            if (ech == 0) xs[wid * 32 + row] = ss; }
        FA_BAR();
        bf16* Ow = BR + (size_t)(b * SEQ + qlo) * BRW + colb;
#pragma unroll
        for (int i = 0; i < 8; ++i) { const int row = 4 * i + erow; const f32x4 x0 = *(const LAS f32x4*)(sg + row * RP + ech * 32), x1 = *(const LAS f32x4*)(sg + row * RP + ech * 32 + 16);
            const v4u og = ogv[i];
            const float tot = xs[wid * 32 + row] + xs[(wid ^ 1) * 32 + row]; const float rstd = 1.0f / sqrtf(tot * (1.f / 256) + EPS);
            v4u w; w.x = pk2(x0.x * rstd * g0.x * sigmoidf_(bflo(og.x)), x0.y * rstd * g0.y * sigmoidf_(bfhi(og.x))); w.y = pk2(x0.z * rstd * g0.z * sigmoidf_(bflo(og.y)), x0.w * rstd * g0.w * sigmoidf_(bfhi(og.y)));
            w.z = pk2(x1.x * rstd * g1.x * sigmoidf_(bflo(og.z)), x1.y * rstd * g1.y * sigmoidf_(bfhi(og.z))); w.w = pk2(x1.z * rstd * g1.z * sigmoidf_(bflo(og.w)), x1.w * rstd * g1.w * sigmoidf_(bfhi(og.w)));
            *(v4u*)(Ow + (size_t)row * BRW) = w; }
    }
    FA_BAR();
#undef FA_ISSUE
}

__device__ __forceinline__ void dstate_unit(const Frame& F, KArgs a, int bh, int c) {
    int lane_ = F.lane; asm volatile("" : "+v"(lane_));
    const int wid = F.wave, lane = lane_, r32 = lane & 31, hi = lane >> 5;
    const int b = bh >> 2, h = bh & 3, db = wid & 3, vh = wid >> 2;
    unsigned char* ws = a->ws;
    const bf16* Zb = (const bf16*)(ws + WS_Z) + (size_t)(b * SEQ + c * MCH) * ZW; const bf16* Kg = Zb + ZK + h * 128; const bf16* Vg = Zb + ZV + h * 256;
    const float* Eg = (const float*)(ws + WS_ML) + ML_ECH + bh * SEQ + c * MCH;
    LAS unsigned char* K_lds = F.lds; LAS unsigned char* V_lds = F.lds + 2 * 16384; LAS unsigned char* E_lds = F.lds + 2 * 16384 + 2 * 32768 + wid * 512;
#pragma unroll
    for (int tt = 0; tt < 2; ++tt) {
        const bf16* kb_ = Kg + (size_t)(tt * 64) * ZW; const bf16* vb_ = Vg + (size_t)(tt * 64) * ZW;
#pragma unroll
        for (int i = 0; i < 2; ++i) { const int X = (wid + 8 * i) * 1024 + lane * 16, sub = X >> 9, within = X & 511;
            const int kk = (sub >> 2) * 8 + (within >> 6), k_ = (kk & ~0xC) | ((kk & 4) << 1) | ((kk & 8) >> 1), col = (sub & 3) * 32 + ((within & 63) >> 1);
            __builtin_amdgcn_global_load_lds((const unsigned*)((const char*)kb_ + (unsigned)(k_ * ZW + col) * 2u), (LAS unsigned*)(K_lds + tt * 16384 + (wid + 8 * i) * 1024), 16, 0, 0); }
#pragma unroll
        for (int i = 0; i < 4; ++i) { const int X = (wid + 8 * i) * 1024 + lane * 16, img = X >> 14, Xi = X & 16383, sub = Xi >> 9, within = Xi & 511;
            const int kk = (sub >> 2) * 8 + (within >> 6), k_ = (kk & ~0xC) | ((kk & 4) << 1) | ((kk & 8) >> 1), col = img * 128 + (sub & 3) * 32 + ((within & 63) >> 1);
            __builtin_amdgcn_global_load_lds((const unsigned*)((const char*)vb_ + (unsigned)(k_ * ZW + col) * 2u), (LAS unsigned*)(V_lds + tt * 32768 + (wid + 8 * i) * 1024), 16, 0, 0); }
        __builtin_amdgcn_global_load_lds((const unsigned*)(Eg + tt * 64 + lane), (LAS unsigned*)(E_lds + tt * 256), 4, 0, 0);
    }
    f32x16 o[4];
#pragma unroll
    for (int d = 0; d < 4; ++d)
#pragma unroll
        for (int r = 0; r < 16; ++r) o[d][r] = 0.f;
    float dnp = 0.f;
    VM_WAIT(); FA_BAR();
    const unsigned kbase = (unsigned)(uintptr_t)K_lds + v_rd_base(lane), vbase = (unsigned)(uintptr_t)V_lds + vh * 16384 + v_rd_base(lane);
    const LAS float* Ew = (const LAS float*)E_lds;
    const unsigned kdb = kbase + db * 512;
#define DS_TR(dst, base, off) asm volatile("ds_read_b64_tr_b16 %0, %1 offset:%2" : "=&v"(dst) : "v"(base), "i"(off) : "memory")
#define DS_STEP(tt, ks) do { s16x4 kl, kh2, v0, v1, v2, v3, v4, v5, v6, v7; const unsigned ka = kdb + (tt) * 16384, vb = vbase + (tt) * 32768; \
        DS_TR(kl, ka, v_rd_off(0, ks, 0)); DS_TR(kh2, ka, v_rd_off(0, ks, 1)); \
        DS_TR(v0, vb, v_rd_off(0, ks, 0)); DS_TR(v1, vb, v_rd_off(0, ks, 1)); DS_TR(v2, vb, v_rd_off(1, ks, 0)); DS_TR(v3, vb, v_rd_off(1, ks, 1)); \
        DS_TR(v4, vb, v_rd_off(2, ks, 0)); DS_TR(v5, vb, v_rd_off(2, ks, 1)); DS_TR(v6, vb, v_rd_off(3, ks, 0)); DS_TR(v7, vb, v_rd_off(3, ks, 1)); \
        const f32x4 e0 = *(const LAS f32x4*)(Ew + (tt) * 64 + (ks) * 16 + hi * 8), e1 = *(const LAS f32x4*)(Ew + (tt) * 64 + (ks) * 16 + hi * 8 + 4); \
        asm volatile("s_waitcnt lgkmcnt(0)" ::: "memory"); __builtin_amdgcn_sched_barrier(0); \
          \
        const float x0 = bf2f((bf16)kl[0]) * e0.x, x1 = bf2f((bf16)kl[1]) * e0.y, x2 = bf2f((bf16)kl[2]) * e0.z, x3 = bf2f((bf16)kl[3]) * e0.w; \
        const float x4 = bf2f((bf16)kh2[0]) * e1.x, x5 = bf2f((bf16)kh2[1]) * e1.y, x6 = bf2f((bf16)kh2[2]) * e1.z, x7 = bf2f((bf16)kh2[3]) * e1.w; \
        dnp += ((x0 + x1) + (x2 + x3)) + ((x4 + x5) + (x6 + x7)); \
        u32x4 aw; aw.x = cvtpk(x0, x1); aw.y = cvtpk(x2, x3); aw.z = cvtpk(x4, x5); aw.w = cvtpk(x6, x7); const bf16x8 af = __builtin_bit_cast(bf16x8, aw); \
        o[0] = __builtin_amdgcn_mfma_f32_32x32x16_bf16(af, (bf16x8){v0[0], v0[1], v0[2], v0[3], v1[0], v1[1], v1[2], v1[3]}, o[0], 0, 0, 0); \
        o[1] = __builtin_amdgcn_mfma_f32_32x32x16_bf16(af, (bf16x8){v2[0], v2[1], v2[2], v2[3], v3[0], v3[1], v3[2], v3[3]}, o[1], 0, 0, 0); \
        o[2] = __builtin_amdgcn_mfma_f32_32x32x16_bf16(af, (bf16x8){v4[0], v4[1], v4[2], v4[3], v5[0], v5[1], v5[2], v5[3]}, o[2], 0, 0, 0); \
        o[3] = __builtin_amdgcn_mfma_f32_32x32x16_bf16(af, (bf16x8){v6[0], v6[1], v6[2], v6[3], v7[0], v7[1], v7[2], v7[3]}, o[3], 0, 0, 0); \
        __builtin_amdgcn_sched_barrier(0); } while (0)
    DS_STEP(0, 0); DS_STEP(0, 1); DS_STEP(0, 2); DS_STEP(0, 3); DS_STEP(1, 0); DS_STEP(1, 1); DS_STEP(1, 2); DS_STEP(1, 3);
#undef DS_STEP
#undef DS_TR
    bf16* D = (bf16*)(ws + WS_DCS) + ((size_t)(bh * 15 + c) * 256 + vh * 128) * 128 + db * 32;
#pragma unroll
    for (int vb2 = 0; vb2 < 4; ++vb2)
#pragma unroll
        for (int g = 0; g < 4; ++g) { v2u w; w.x = cvtpk(o[vb2][4 * g], o[vb2][4 * g + 1]); w.y = cvtpk(o[vb2][4 * g + 2], o[vb2][4 * g + 3]);
            *(v2u*)(D + (size_t)(vb2 * 32 + r32) * 128 + 8 * g + 4 * hi) = w; }
    const float dn = swap_add(dnp);
    if (vh == 0 && hi == 0) ((float*)(ws + WS_ML))[ML_DN + (bh * 15 + c) * 128 + db * 32 + r32] = dn;
    FA_BAR();
}
__device__ __forceinline__ void dstate_phase(const Frame& F, KArgs a) {
    const int bx = F.cid, vcu = (F.G % 8 == 0) ? (bx % 8) * (F.G / 8) + bx / 8 : bx;
    for (int it = vcu; it < 32 * 15; it += F.G) dstate_unit(F, a, it / 15, it % 15);
}
__device__ __forceinline__ void dstate_scan(const Frame& F, KArgs a) {
    unsigned char* ws = a->ws; const float* ML = (const float*)(ws + WS_ML); float* MLw = (float*)(ws + WS_ML);
    for (int idx = F.gw * 64 + F.lane; idx < 32 * 4096; idx += F.NGW * 64) {
        const int bh = idx >> 12, e8 = idx & 4095;
        bf16* p = (bf16*)(ws + WS_DCS) + (size_t)bh * 15 * 32768 + e8 * 8;
        v4u x[15];
#pragma unroll
        for (int c = 0; c < 15; ++c) x[c] = *(const v4u*)(p + (size_t)c * 32768);
        float S[8], fav[15], fbv[15];
#pragma unroll
        for (int c = 0; c < 15; ++c) { fav[c] = ML[ML_FA + bh * 16 + c]; fbv[c] = ML[ML_FB + bh * 16 + c]; }
#pragma unroll
        for (int j = 0; j < 8; ++j) S[j] = 0.f;
#pragma unroll
        for (int c = 0; c < 15; ++c) { const float fa = fav[c], fb = fbv[c];
            S[0] = S[0] * fa + bflo(x[c].x) * fb; S[1] = S[1] * fa + bfhi(x[c].x) * fb; S[2] = S[2] * fa + bflo(x[c].y) * fb; S[3] = S[3] * fa + bfhi(x[c].y) * fb;
            S[4] = S[4] * fa + bflo(x[c].z) * fb; S[5] = S[5] * fa + bfhi(x[c].z) * fb; S[6] = S[6] * fa + bflo(x[c].w) * fb; S[7] = S[7] * fa + bfhi(x[c].w) * fb;
            v4u o; o.x = pk2(S[0], S[1]); o.y = pk2(S[2], S[3]); o.z = pk2(S[4], S[5]); o.w = pk2(S[6], S[7]);
            *(v4u*)(p + (size_t)c * 32768) = o; }
    }
    for (int idx = F.gw * 64 + F.lane; idx < 32 * 128; idx += F.NGW * 64) {
        const int bh = idx >> 7, d = idx & 127; float n = 0.f; float dv[15], fav[15], fbv[15];
#pragma unroll
        for (int c = 0; c < 15; ++c) { dv[c] = ML[ML_DN + (bh * 15 + c) * 128 + d]; fav[c] = ML[ML_FA + bh * 16 + c]; fbv[c] = ML[ML_FB + bh * 16 + c]; }
#pragma unroll
        for (int c = 0; c < 15; ++c) { n = n * fav[c] + dv[c] * fbv[c]; MLw[ML_DN + (bh * 15 + c) * 128 + d] = n; }
    }
}
template <int MODE>
__device__ __forceinline__ void phase(const Frame& F, KArgs a, int l) {
    constexpr int NQB = MODE == 0 ? 8 : 16, NPAIR = NQB / 2;
    const int bx = F.cid, vcu = (F.G % 8 == 0) ? (bx % 8) * (F.G / 8) + bx / 8 : bx;
    for (int it = vcu; it < 256; it += F.G) { const int bh = it / NPAIR, p = it % NPAIR;
        for (int u = 0; u < 2; ++u) unit<MODE>(F, a, l, bh, u ? p : NQB - 1 - p); }
}
}

using pg8::Unit; using pg8::cvt_pk_bf16;
struct EpiZ {
    static constexpr bool PERM = true, CHAIN = false; static constexpr int NST = 16;
    bf16* Z; float* IFB;
    __device__ __forceinline__ void operator()(const f32x4 (&acc)[2][2][4][2], const Unit& u, int wr, int wc, int fr, int fq) const {
        const int row0 = u.pm * 256 + wr * 64 + fr, col0 = u.pn * 256 + wc * 32 + 8 * fq;
        const bool gate_tile = (u.pn == 15) && (wc == 2) && (fq == 0);
#pragma unroll
        for (int ai = 0; ai < 2; ++ai)
#pragma unroll
            for (int m = 0; m < 4; ++m) { const int row = row0 + ai * 128 + m * 16; bf16* rowp = Z + (size_t)row * ZW + col0;
#pragma unroll
                for (int bj = 0; bj < 2; ++bj) { f32x4 v0 = acc[ai][bj][m][0], v1 = acc[ai][bj][m][1];
                    if (bj == 0 && gate_tile) { *(f32x4*)(IFB + (size_t)row * 8) = v0; *(f32x4*)(IFB + (size_t)row * 8 + 4) = v1; }
                    pg8::u32x4 w; w.x = cvt_pk_bf16(v0[0], v0[1]); w.y = cvt_pk_bf16(v0[2], v0[3]); w.z = cvt_pk_bf16(v1[0], v1[1]); w.w = cvt_pk_bf16(v1[2], v1[3]);
                    *(pg8::u32x4*)(rowp + bj * 128) = w; } }
    }
};
struct EpiZG {
    static constexpr bool PERM = true, CHAIN = false; static constexpr int NST = 16;
    bf16* Z;
    __device__ __forceinline__ void operator()(const f32x4 (&acc)[2][2][4][2], const Unit& u, int wr, int wc, int fr, int fq) const {
        const int row0 = u.pm * 256 + wr * 64 + fr, gcol0 = (u.pn - NZO) * 256 + wc * 32 + 8 * fq;
        if (u.pn < NZO) {
            const int col0 = ZO + u.pn * 256 + wc * 32 + 8 * fq;
#pragma unroll
            for (int ai = 0; ai < 2; ++ai)
#pragma unroll
                for (int m = 0; m < 4; ++m) { bf16* rowp = Z + (size_t)(row0 + ai * 128 + m * 16) * ZW + col0;
#pragma unroll
                    for (int bj = 0; bj < 2; ++bj) { const f32x4 v0 = acc[ai][bj][m][0], v1 = acc[ai][bj][m][1];
                        pg8::u32x4 w; w.x = cvt_pk_bf16(v0[0], v0[1]); w.y = cvt_pk_bf16(v0[2], v0[3]); w.z = cvt_pk_bf16(v1[0], v1[1]); w.w = cvt_pk_bf16(v1[2], v1[3]);
                        *(pg8::u32x4*)(rowp + bj * 128) = w; } }
            return; }
#pragma unroll
        for (int ai = 0; ai < 2; ++ai)
#pragma unroll
            for (int m = 0; m < 4; ++m) { const int row = row0 + ai * 128 + m * 16;
#pragma unroll
                for (int bj = 0; bj < 2; ++bj) { const f32x4 v0 = acc[ai][bj][m][0], v1 = acc[ai][bj][m][1];
                    unsigned q[8];
#pragma unroll
                    for (int j = 0; j < 4; ++j) { q[j] = (unsigned)(sigmoidf_(v0[j]) * 255.f + 0.5f); q[4 + j] = (unsigned)(sigmoidf_(v1[j]) * 255.f + 0.5f); }
                    v2u w8; w8.x = q[0] | (q[1] << 8) | (q[2] << 16) | (q[3] << 24); w8.y = q[4] | (q[5] << 8) | (q[6] << 16) | (q[7] << 24);
                    *(v2u*)((unsigned char*)Z + (size_t)row * (ZW * 2) + ZG * 2 + gcol0 + bj * 128) = w8; } }
    }
};
struct EpiRowScale {
    static constexpr bool PERM = true, CHAIN = false; static constexpr int NST = 16;
    bf16* O; int ldc; const float* rs; int which;
    __device__ __forceinline__ void operator()(const f32x4 (&acc)[2][2][4][2], const Unit& u, int wr, int wc, int fr, int fq) const {
        const int row0 = u.pm * 256 + wr * 64 + fr, col0 = u.pn * 256 + wc * 32 + 8 * fq;
        float scv[2][4];
#pragma unroll
        for (int ai = 0; ai < 2; ++ai)
#pragma unroll
            for (int m = 0; m < 4; ++m) scv[ai][m] = rs[(row0 + ai * 128 + m * 16) * 2 + which];
#pragma unroll
        for (int ai = 0; ai < 2; ++ai)
#pragma unroll
            for (int m = 0; m < 4; ++m) { const int row = row0 + ai * 128 + m * 16; const float sc = scv[ai][m]; bf16* rowp = O + (size_t)row * ldc + col0;
#pragma unroll
                for (int bj = 0; bj < 2; ++bj) { const f32x4 v0 = acc[ai][bj][m][0] * sc, v1 = acc[ai][bj][m][1] * sc;
                    pg8::u32x4 w; w.x = cvt_pk_bf16(v0[0], v0[1]); w.y = cvt_pk_bf16(v0[2], v0[3]); w.z = cvt_pk_bf16(v1[0], v1[1]); w.w = cvt_pk_bf16(v1[2], v1[3]);
                    *(pg8::u32x4*)(rowp + bj * 128) = w; } }
    }
};
struct EpiPool {
    static constexpr bool PERM = true, CHAIN = false; static constexpr int NST = 16;
    bf16* BR; const float* bp; const float* sp;
    __device__ __forceinline__ void operator()(const f32x4 (&acc)[2][2][4][2], const Unit& u, int wr, int wc, int fr, int fq) const {
        const int row0 = u.pm * 256 + wr * 64 + fr, col0 = u.pn * 256 + wc * 32 + 8 * fq;
        f32x4 bv[2][2], sv[2][2];
#pragma unroll
        for (int bj = 0; bj < 2; ++bj)
#pragma unroll
            for (int n = 0; n < 2; ++n) { bv[bj][n] = *(const f32x4*)(bp + col0 + bj * 128 + 4 * n); sv[bj][n] = *(const f32x4*)(sp + col0 + bj * 128 + 4 * n); }
#pragma unroll
        for (int ai = 0; ai < 2; ++ai)
#pragma unroll
            for (int m = 0; m < 4; ++m) { const int row = row0 + ai * 128 + m * 16; bf16* rowp = BR + (size_t)row * BRW + 2048 + col0;
#pragma unroll
                for (int bj = 0; bj < 2; ++bj) { const f32x4 v0 = (acc[ai][bj][m][0] + bv[bj][0]) * sv[bj][0], v1 = (acc[ai][bj][m][1] + bv[bj][1]) * sv[bj][1];
                    pg8::u32x4 w; w.x = cvt_pk_bf16(v0[0], v0[1]); w.y = cvt_pk_bf16(v0[2], v0[3]); w.z = cvt_pk_bf16(v1[0], v1[1]); w.w = cvt_pk_bf16(v1[2], v1[3]);
                    *(pg8::u32x4*)(rowp + bj * 128) = w; } }
    }
};
template <bool FIRST> struct EpiMerge {
    static constexpr bool PERM = true, CHAIN = false; static constexpr int NST = 16;
    bf16* MG; const bf16* Zg;
    __device__ __forceinline__ void operator()(const f32x4 (&acc)[2][2][4][2], const Unit& u, int wr, int wc, int fr, int fq) const {
        const int row0 = u.pm * 256 + wr * 64 + fr, col0 = u.pn * 256 + wc * 32 + 8 * fq;
#pragma unroll
        for (int ai = 0; ai < 2; ++ai)
#pragma unroll
            for (int m = 0; m < 4; ++m) { const int row = row0 + ai * 128 + m * 16; bf16* rowp = MG + (size_t)row * DM + col0; const bf16* gp = Zg + (size_t)row * ZW + col0;
#pragma unroll
                for (int bj = 0; bj < 2; ++bj) { const pg8::u32x4 gq = *(const pg8::u32x4*)(gp + bj * 128);
                    f32x4 v0 = acc[ai][bj][m][0], v1 = acc[ai][bj][m][1];
                    v0[0] *= bflo(gq.x); v0[1] *= bfhi(gq.x); v0[2] *= bflo(gq.y); v0[3] *= bfhi(gq.y); v1[0] *= bflo(gq.z); v1[1] *= bfhi(gq.z); v1[2] *= bflo(gq.w); v1[3] *= bfhi(gq.w);
                    if (!FIRST) { const pg8::u32x4 oq = *(const pg8::u32x4*)(rowp + bj * 128);
                        v0[0] += bflo(oq.x); v0[1] += bfhi(oq.x); v0[2] += bflo(oq.y); v0[3] += bfhi(oq.y); v1[0] += bflo(oq.z); v1[1] += bfhi(oq.z); v1[2] += bflo(oq.w); v1[3] += bfhi(oq.w); }
                    pg8::u32x4 w; w.x = cvt_pk_bf16(v0[0], v0[1]); w.y = cvt_pk_bf16(v0[2], v0[3]); w.z = cvt_pk_bf16(v1[0], v1[1]); w.w = cvt_pk_bf16(v1[2], v1[3]);
                    *(pg8::u32x4*)(rowp + bj * 128) = w; } }
    }
};
struct EpiMergeH {
    static constexpr bool PERM = true, CHAIN = true; static constexpr int NST = 0;
    bf16* MG; const bf16* Zg;
    __device__ __forceinline__ bool chain(f32x4 (&acc)[2][2][4][2], const Unit& u, int wr, int wc, int fr, int fq) const {
        const int row0 = u.pm * 256 + wr * 64 + fr, col0 = u.pn * 256 + wc * 32 + 8 * fq, br = u.kofs >> 11;
#pragma unroll
        for (int ai = 0; ai < 2; ++ai) {
            v2u gq[4][2], hq[4][2];
#pragma unroll
            for (int m = 0; m < 4; ++m) { const unsigned char* gp = (const unsigned char*)Zg + (size_t)(row0 + ai * 128 + m * 16) * (ZW * 2) + col0 + br * 2048;
#pragma unroll
                for (int bj = 0; bj < 2; ++bj) { gq[m][bj] = *(const v2u*)(gp + bj * 128); if (br < 2) hq[m][bj] = *(const v2u*)(gp + 2048 + bj * 128); else hq[m][bj] = (v2u){0u, 0u}; } }
#pragma unroll
            for (int m = 0; m < 4; ++m) { const int row = row0 + ai * 128 + m * 16;
#pragma unroll
                for (int bj = 0; bj < 2; ++bj) { const v2u g_ = gq[m][bj], h_ = hq[m][bj];
                    float f[8] = {(float)(g_.x & 255u), (float)((g_.x >> 8) & 255u), (float)((g_.x >> 16) & 255u), (float)(g_.x >> 24), (float)(g_.y & 255u), (float)((g_.y >> 8) & 255u), (float)((g_.y >> 16) & 255u), (float)(g_.y >> 24)};
                    if (br < 2) {
                        const float d[8] = {(float)(h_.x & 255u), (float)((h_.x >> 8) & 255u), (float)((h_.x >> 16) & 255u), (float)(h_.x >> 24), (float)(h_.y & 255u), (float)((h_.y >> 8) & 255u), (float)((h_.y >> 16) & 255u), (float)(h_.y >> 24)};
#pragma unroll
                        for (int j = 0; j < 8; ++j) f[j] = f[j] * __builtin_amdgcn_rcpf(fmaxf(d[j], 0.5f)); }
                    else {
#pragma unroll
                        for (int j = 0; j < 8; ++j) f[j] *= (1.f / 255.f); }
#pragma unroll
                    for (int j = 0; j < 4; ++j) { acc[ai][bj][m][0][j] *= f[j]; acc[ai][bj][m][1][j] *= f[4 + j]; }
                    if (br == 2) { const f32x4 v0 = acc[ai][bj][m][0], v1 = acc[ai][bj][m][1];
                        pg8::u32x4 w; w.x = cvt_pk_bf16(v0[0], v0[1]); w.y = cvt_pk_bf16(v0[2], v0[3]); w.z = cvt_pk_bf16(v1[0], v1[1]); w.w = cvt_pk_bf16(v1[2], v1[3]);
                        *(pg8::u32x4*)(MG + (size_t)row * DM + col0 + bj * 128) = w; } } }
            asm volatile("" ::: "memory");
        }
        return br < 2;
    }
};
template <bool INBF, bool OUTBF> struct EpiResid {
    static constexpr bool PERM = INBF && OUTBF, CHAIN = false;
    static constexpr int NST = (INBF && OUTBF) ? 16 : 32;
    const void* xin; void* xout; const float* gate;
    __device__ __forceinline__ void operator()(const f32x4 (&acc)[2][2][4][2], const Unit& u, int wr, int wc, int fr, int fq) const {
        const int row0 = u.pm * 256 + wr * 64 + fr;
        if (PERM) {
            const int col0 = u.pn * 256 + wc * 32 + 8 * fq; const float* gb = gate + (size_t)(u.pm >> 3) * ADA + col0;
            f32x4 gv[2][2];
#pragma unroll
            for (int bj = 0; bj < 2; ++bj)
#pragma unroll
                for (int n = 0; n < 2; ++n) gv[bj][n] = *(const f32x4*)(gb + bj * 128 + n * 4);
#pragma unroll
            for (int ai = 0; ai < 2; ++ai) { pg8::u32x4 xq[4][2];
#pragma unroll
                for (int m = 0; m < 4; ++m)
#pragma unroll
                    for (int bj = 0; bj < 2; ++bj) xq[m][bj] = *(const pg8::u32x4*)((const bf16*)xin + (size_t)(row0 + ai * 128 + m * 16) * DM + col0 + bj * 128);
#pragma unroll
                for (int m = 0; m < 4; ++m) { const size_t off = (size_t)(row0 + ai * 128 + m * 16) * DM + col0;
#pragma unroll
                    for (int bj = 0; bj < 2; ++bj) {
                        const f32x4 v0 = gv[bj][0] * acc[ai][bj][m][0], v1 = gv[bj][1] * acc[ai][bj][m][1];
                        pg8::u32x4 w; w.x = cvt_pk_bf16(bflo(xq[m][bj].x) + v0[0], bfhi(xq[m][bj].x) + v0[1]); w.y = cvt_pk_bf16(bflo(xq[m][bj].y) + v0[2], bfhi(xq[m][bj].y) + v0[3]);
                        w.z = cvt_pk_bf16(bflo(xq[m][bj].z) + v1[0], bfhi(xq[m][bj].z) + v1[1]); w.w = cvt_pk_bf16(bflo(xq[m][bj].w) + v1[2], bfhi(xq[m][bj].w) + v1[3]);
                        *(pg8::u32x4*)((bf16*)xout + off + bj * 128) = w; } }
                asm volatile("" ::: "memory"); }
        } else {
            const int col0 = u.pn * 256 + wc * 32 + 4 * fq; const float* gb = gate + (size_t)(u.pm >> 3) * ADA + col0;
            f32x4 gv[2][2];
#pragma unroll
            for (int bj = 0; bj < 2; ++bj)
#pragma unroll
                for (int n = 0; n < 2; ++n) gv[bj][n] = *(const f32x4*)(gb + bj * 128 + n * 16);
#pragma unroll
            for (int ai = 0; ai < 2; ++ai)
#pragma unroll
                for (int mp = 0; mp < 2; ++mp) { f32x4 xv[2][2][2];
#pragma unroll
                    for (int mm = 0; mm < 2; ++mm) { const size_t off = (size_t)(row0 + ai * 128 + (2 * mp + mm) * 16) * DM + col0;
#pragma unroll
                        for (int bj = 0; bj < 2; ++bj)
#pragma unroll
                            for (int n = 0; n < 2; ++n) {
                                if (INBF) { const v2u xq = *(const v2u*)((const bf16*)xin + off + bj * 128 + n * 16); xv[mm][bj][n] = (f32x4){bflo(xq.x), bfhi(xq.x), bflo(xq.y), bfhi(xq.y)}; }
                                else xv[mm][bj][n] = *(const f32x4*)((const float*)xin + off + bj * 128 + n * 16); } }
#pragma unroll
                    for (int mm = 0; mm < 2; ++mm) { const int m = 2 * mp + mm; const size_t off = (size_t)(row0 + ai * 128 + m * 16) * DM + col0;
#pragma unroll
                        for (int bj = 0; bj < 2; ++bj)
#pragma unroll
                            for (int n = 0; n < 2; ++n) {
                                const f32x4 r = xv[mm][bj][n] + gv[bj][n] * acc[ai][bj][m][n];
                                if (OUTBF) { v2u w; w.x = cvt_pk_bf16(r[0], r[1]); w.y = cvt_pk_bf16(r[2], r[3]); *(v2u*)((bf16*)xout + off + bj * 128 + n * 16) = w; }
                                else *(f32x4*)((float*)xout + off + bj * 128 + n * 16) = r; } }
                    asm volatile("" ::: "memory"); }
        }
    }
};
struct EpiSwiglu {
    static constexpr bool PERM = true, CHAIN = false; static constexpr int NST = 8;
    bf16* ACT;
    __device__ __forceinline__ void operator()(const f32x4 (&acc)[2][2][4][2], const Unit& u, int wr, int wc, int fr, int fq) const {
        const int row0 = u.pm * 256 + wr * 64 + fr, col0 = u.pn * 128 + wc * 32 + 8 * fq;
#pragma unroll
        for (int ai = 0; ai < 2; ++ai)
#pragma unroll
            for (int m = 0; m < 4; ++m) { bf16* rowp = ACT + (size_t)(row0 + ai * 128 + m * 16) * FF + col0;
                f32x4 v0, v1;
#pragma unroll
                for (int j = 0; j < 4; ++j) { const float g0 = acc[ai][0][m][0][j], g1 = acc[ai][0][m][1][j]; v0[j] = g0 * sigmoidf_(g0) * acc[ai][1][m][0][j]; v1[j] = g1 * sigmoidf_(g1) * acc[ai][1][m][1][j]; }
                pg8::u32x4 w; w.x = cvt_pk_bf16(v0[0], v0[1]); w.y = cvt_pk_bf16(v0[2], v0[3]); w.z = cvt_pk_bf16(v1[0], v1[1]); w.w = cvt_pk_bf16(v1[2], v1[3]);
                *(pg8::u32x4*)rowp = w; }
    }
};

constexpr int NP = 12;
constexpr int NGP = 2 + DEPTH * NP;
__global__ void __launch_bounds__(NWAVES * 64, 2) hybrid_fwd(Args args_unused) {
    extern __shared__ __attribute__((aligned(16))) unsigned char lds[];
    Frame F;
    F.lds = (LAS unsigned char*)lds;
    F.tid = threadIdx.x; F.lane = F.tid & 63; F.wave = __builtin_amdgcn_readfirstlane(F.tid >> 6);
    F.G = gridDim.x; F.gw = blockIdx.x * NWAVES + F.wave; F.NGW = F.G * NWAVES;
    volatile LAS unsigned* MISC = (volatile LAS unsigned*)(F.lds + MISC_OFF);
    for (int u = F.tid; u < (LDS_BYTES - LDSCTL_OFF) / 4; u += NWAVES * 64) ((LAS unsigned*)(F.lds + LDSCTL_OFF))[u] = 0u;
    __syncthreads();
    KArgs ka0 = (KArgs)__builtin_amdgcn_kernarg_segment_ptr();
    const int lo = ka0->gp_lo, hi = ka0->gp_hi;
    XcdBarrier bar; bar.bar = (unsigned*)(ka0->ws + WS_CTL) + CW_BAR; bar.x = 0; bar.st = nullptr; bar.wave = F.wave;
    if (hi - lo > 1) bar = xcd_barrier_post((unsigned*)(ka0->ws + WS_CTL) + CW_BAR, MISC + 8, F.wave);
    F.cid = blockIdx.x;
#define IN(k) (lo <= (k) && (k) < hi && relaunder(F))
#define KA() KArgs a = ka0; asm volatile("" : "+s"(a)); unsigned char* ws = a->ws; LAS unsigned char* ring = F.lds
#define SEAM(k) do { if ((k) + 1 < hi) xcd_barrier(bar); } while (0)

    if (IN(0)) { KA(); (void)ws; (void)ring; adaln_partials(F, a); rope_table(F, a); SEAM(0);
        if (hi > 1) {
            if (F.tid == 0) { unsigned* bw = (unsigned*)(ws + WS_CTL) + CW_BAR; bool even = (F.G % 8 == 0); int nxcc = 0;
                for (int j = 0; j < 16; ++j) { const unsigned c = xb_ld(&bw[XB_XCNT(j)]); if (c) { ++nxcc; if (c != (unsigned)(F.G / 8)) even = false; } }
                const unsigned x = xb_xcc_id(), rk = MISC[10];
                MISC[11] = (even && nxcc == 8 && x < 8u) ? rk * 8u + x : (unsigned)blockIdx.x; }
            __syncthreads();
            F.cid = (int)__builtin_amdgcn_readfirstlane(MISC[11]);
        } }
    if (IN(1)) { KA(); (void)ws; (void)ring; adaln_reduce(F, a); SEAM(1); }

    for (int l = 0; l < DEPTH; ++l) {
        const int g0 = 2 + l * NP;
        if (IN(g0 + 0)) { KA(); (void)ring;
#pragma unroll 1
            for (int rep = 0; rep < REP_THIN; ++rep) { convert_weights(F, a, l); __syncthreads();
            if (l == 0) norm_rows<false, true>(F, a->x, a->g_norm1 + l * DM, (const float*)(ws + WS_MOD) + (size_t)l * 8 * ADA, 0, 1, (bf16*)(ws + WS_H), ws + WS_H8);
            else norm_rows<true, true>(F, ws + WS_XB, a->g_norm1 + l * DM, (const float*)(ws + WS_MOD) + (size_t)l * 8 * ADA, 0, 1, (bf16*)(ws + WS_H), ws + WS_H8); }
            SEAM(g0 + 0); }
        if (IN(g0 + 1)) { KA();
            { pg8::Gemm g{(const bf16*)(ws + WS_H), (const bf16*)(ws + WS_WIN), M, NZB * 256, DM, DM, DM, 0}; pg8::SkipOrder S; S.init(M, NZB * 256, F.G, F.cid); S.lo = ZO / 256; S.gap = NZO;
              EpiZ E{(bf16*)(ws + WS_Z), (float*)(ws + WS_IF)};
              pg8::gemm_phase<EpiZ, pg8::SkipOrder>(ring, g, S, E, F.tid); }
            relaunder(F);
            { pg8::Gemm g{(const bf16*)(ws + WS_H8), (const bf16*)(ws + WS_W8), M, NZG * 256, DM / 2, DM / 2, DM / 2, 0}; pg8::StaticOrder S; S.init(M, NZG * 256, F.G, F.cid);
              EpiZG E{(bf16*)(ws + WS_Z)};
              pg8::gemm_phase<EpiZG, pg8::StaticOrder, true, true>(ring, g, S, E, F.tid); }
            SEAM(g0 + 1);
        }
        if (IN(g0 + 2)) { KA(); (void)ws; (void)ring;
#pragma unroll 1
            for (int rep = 0; rep < REP_THIN; ++rep) { prep_pooled(F, a); prep_rstd(F, a); prep_mlstm(F, a, l); }
            SEAM(g0 + 2); }
        if (IN(g0 + 3)) { KA();
            bf16* Z = (bf16*)(ws + WS_Z); bf16* BR = (bf16*)(ws + WS_BR);
            { pg8::Gemm g{Z + ZQL, (const bf16*)(ws + WS_WUQ), M, QW, 512, ZW, 512, 0}; pg8::StaticOrder S; S.init(M, QW, F.G, F.cid);
              EpiRowScale E{(bf16*)(ws + WS_QRAW), QW, (const float*)(ws + WS_RSTD), 0}; pg8::gemm_phase<EpiRowScale, pg8::StaticOrder>(ring, g, S, E, F.tid); }
            relaunder(F);
            { pg8::Gemm g{Z + ZKVL, (const bf16*)(ws + WS_WUKV), M, KVW, 256, ZW, 256, 0}; pg8::StaticOrder S; S.init(M, KVW, F.G, F.cid);
              EpiRowScale E{(bf16*)(ws + WS_KVRAW), KVW, (const float*)(ws + WS_RSTD), 1}; pg8::gemm_phase<EpiRowScale, pg8::StaticOrder>(ring, g, S, E, F.tid); }
            relaunder(F);
            { pg8::Gemm g{BR, (const bf16*)(ws + WS_WPOOL), M, 1024, 256, BRW, 256, 512}; pg8::StaticOrder S;
              if (F.G == 256) S.init(M, 1024, 128, F.cid >= 128 ? F.cid - 128 : (1 << 20)); else S.init(M, 1024, F.G, F.cid);
              EpiPool E{BR, a->b_pool + l * 1024, a->s_pool + l * 1024}; pg8::gemm_phase<EpiPool, pg8::StaticOrder>(ring, g, S, E, F.tid); }
#if FA_MLSTM && ML_CHUNKED
            relaunder(F); fa::dstate_phase(F, a);
#endif
            SEAM(g0 + 3);
        }
        if (IN(g0 + 4)) { KA(); (void)ws; (void)ring; kstats(F, a, l);
#if FA_MLSTM && ML_CHUNKED
            relaunder(F); fa::dstate_scan(F, a);
#endif
            SEAM(g0 + 4); }
#if FA_MLA
        if (IN(g0 + 5)) { KA(); (void)ws; (void)ring;
#pragma unroll 1
            for (int rep = 0; rep < REP_ATT; ++rep) { fa::phase<0>(F, a, l); relaunder(F); fa::phase<1>(F, a, l); }
            SEAM(g0 + 5); }
#endif
        if (IN(g0 + 7)) { KA();
            bf16* Z = (bf16*)(ws + WS_Z); bf16* BR = (bf16*)(ws + WS_BR); bf16* MG = (bf16*)(ws + WS_MERGED); const bf16* WB = (const bf16*)(ws + WS_WBR);
            pg8::SegOrder<3> S; S.init(M, DM, F.G, F.cid); S.seg_bytes = 2048;
            { pg8::Gemm g{BR, WB, M, DM, 1024, BRW, 3072, 0}; EpiMergeH E{MG, Z + ZG}; pg8::gemm_phase<EpiMergeH, pg8::SegOrder<3>>(ring, g, S, E, F.tid); }
            SEAM(g0 + 7);
        }
        if (IN(g0 + 8)) { KA();
            pg8::Gemm g{(const bf16*)(ws + WS_MERGED), (const bf16*)(ws + WS_WOUT), M, DM, DM, DM, DM, 0}; pg8::StaticOrder S; S.init(M, DM, F.G, F.cid);
            const float* gate = (const float*)(ws + WS_MOD) + (size_t)l * 8 * ADA + 2 * DM;
            if (l == 0) { EpiResid<false, true> E{a->x, ws + WS_XB, gate}; pg8::gemm_phase<EpiResid<false, true>, pg8::StaticOrder>(ring, g, S, E, F.tid); }
            else { relaunder(F); EpiResid<true, true> E{ws + WS_XB, ws + WS_XB, gate}; pg8::gemm_phase<EpiResid<true, true>, pg8::StaticOrder>(ring, g, S, E, F.tid); }
            SEAM(g0 + 8);
        }
        if (IN(g0 + 9)) { KA(); (void)ring;
#pragma unroll 1
            for (int rep = 0; rep < REP_THIN; ++rep) norm_rows<true>(F, ws + WS_XB, a->g_norm2 + l * DM, (const float*)(ws + WS_MOD) + (size_t)l * 8 * ADA, 3, 4, (bf16*)(ws + WS_H));
            SEAM(g0 + 9); }
        if (IN(g0 + 10)) { KA();
            pg8::Gemm g{(const bf16*)(ws + WS_H), (const bf16*)(ws + WS_WFFI), M, 2 * FF, DM, DM, DM, 0}; pg8::StaticOrder S; S.init(M, 2 * FF, F.G, F.cid);
            EpiSwiglu E{(bf16*)(ws + WS_Z)};
            pg8::gemm_phase<EpiSwiglu, pg8::StaticOrder>(ring, g, S, E, F.tid);
            if (REP_G > 1) { relaunder(F); pg8::gemm_phase<EpiSwiglu, pg8::StaticOrder>(ring, g, S, E, F.tid); }
            SEAM(g0 + 10);
        }
        if (IN(g0 + 11)) { KA();
            pg8::Gemm g{(const bf16*)(ws + WS_Z), (const bf16*)(ws + WS_WFFO), M, DM, FF, FF, FF, 0}; pg8::StaticOrder S; S.init(M, DM, F.G, F.cid);
            const float* gate = (const float*)(ws + WS_MOD) + (size_t)l * 8 * ADA + 5 * DM;
            if (l + 1 < DEPTH) { EpiResid<true, true> E{ws + WS_XB, ws + WS_XB, gate}; pg8::gemm_phase<EpiResid<true, true>, pg8::StaticOrder>(ring, g, S, E, F.tid); }
            else { relaunder(F); EpiResid<true, false> E{ws + WS_XB, a->out, gate}; pg8::gemm_phase<EpiResid<true, false>, pg8::StaticOrder>(ring, g, S, E, F.tid); }
            SEAM(g0 + 11);
        }
    }
#undef IN
#undef KA
#undef SEAM
}

extern "C" void kernel_launch(void* const* d_in, const int* in_sizes, int n_in, void* d_out, int out_size, void* d_ws, size_t ws_size, hipStream_t stream) {
    static int grid = 0;
    if (grid == 0) {
        if (n_in != 22 || in_sizes[0] != M * DM || out_size != M * DM || ws_size < WS_END) { fprintf(stderr, "kernel_launch: unexpected shapes (n_in %d, in0 %d, out %d, ws %zu); nothing launched\n", n_in, n_in > 0 ? in_sizes[0] : -1, out_size, ws_size); grid = -1; return; }
        int dev = 0, cus = 0, per_cu = 0;
        if (hipGetDevice(&dev) != hipSuccess || hipDeviceGetAttribute(&cus, hipDeviceAttributeMultiprocessorCount, dev) != hipSuccess) { grid = -1; return; }
        if (hipFuncSetAttribute((const void*)hybrid_fwd, hipFuncAttributeMaxDynamicSharedMemorySize, LDS_BYTES) != hipSuccess) { fprintf(stderr, "kernel_launch: hipFuncSetAttribute failed\n"); grid = -1; return; }
        if (hipOccupancyMaxActiveBlocksPerMultiprocessor(&per_cu, (const void*)hybrid_fwd, NWAVES * 64, LDS_BYTES) != hipSuccess || per_cu < 1) { fprintf(stderr, "kernel_launch: occupancy query reports %d\n", per_cu); }
        (void)hipGetLastError();
        grid = cus;
    }
    if (grid < 0) return;
    (void)hipMemsetAsync((char*)d_ws + WS_CTL, 0, CTL_ZERO_BYTES, stream);
    Args a{};
    const float** ap = (const float**)&a;
    for (int i = 0; i < 22; ++i) ap[i] = (const float*)d_in[i];
    a.out = (float*)d_out; a.ws = (unsigned char*)d_ws;
#if MK_PER_PHASE
    for (int gp = 0; gp < NGP; ++gp) { a.gp_lo = gp; a.gp_hi = gp + 1; hipLaunchKernelGGL(hybrid_fwd, dim3(grid), dim3(NWAVES * 64), LDS_BYTES, stream, a); }
#else
    a.gp_lo = 0; a.gp_hi = NGP; hipLaunchKernelGGL(hybrid_fwd, dim3(grid), dim3(NWAVES * 64), LDS_BYTES, stream, a);
#endif
}
```
